# Optimizing an MI355X kernel written in HIP

```python
import math
import jax, jax.numpy as jnp
from jax import lax
import numpy as np

D_MODEL = 1024
BATCH = 4
SEQ = 8192
DEPTH = 1

MEM_LEN = 256
MLA_HEADS = 4
QK_NOPE_DIM = 128
QK_ROPE_DIM = 64
QK_DIM = QK_NOPE_DIM + QK_ROPE_DIM
V_HEAD_DIM = 128
Q_LORA_RANK = 384
KV_LORA_RANK = 256
MLA_WIDTH = MLA_HEADS * V_HEAD_DIM
ROPE_THETA = 10000.0
Q_BLOCK = 128
LRU_WIDTH = D_MODEL - MLA_WIDTH
LRU_BLOCKS = 8
LRU_BLOCK_DIM = LRU_WIDTH // LRU_BLOCKS
CONV_WIDTH = 4
LRU_C = 8.0
IN_COLS = Q_LORA_RANK + KV_LORA_RANK + QK_ROPE_DIM + 2 * LRU_WIDTH
XA_HEADS = 4
XA_HEAD_DIM = 128
XA_WIDTH = XA_HEADS * XA_HEAD_DIM
D_FF = 2816
EPS = 1e-6
NEG_INF = -1e30

kernel_name = "hymba_mla_rglru_macaron_sandwich"


def rmsnorm(x, g):
    xf = x.astype(jnp.float32)
    y = xf * lax.rsqrt(jnp.mean(xf * xf, axis=-1, keepdims=True) + EPS)
    return (y * g.astype(jnp.float32)).astype(x.dtype)


def swiglu(h, w_gu, w_down):
    g, u = jnp.split(h @ w_gu, 2, axis=-1)
    return (jax.nn.silu(g) * u) @ w_down


def rope_tables(positions):
    inv = ROPE_THETA ** (-jnp.arange(0, QK_ROPE_DIM, 2, dtype=jnp.float32) / QK_ROPE_DIM)
    ang = positions.astype(jnp.float32)[..., None] * inv
    return jnp.cos(ang), jnp.sin(ang)


def apply_rope(x, cos, sin):
    xf = x.astype(jnp.float32)
    x1, x2 = jnp.split(xf, 2, axis=-1)
    return jnp.concatenate([x1 * cos - x2 * sin, x2 * cos + x1 * sin], axis=-1).astype(x.dtype)


def mla(c_q, c_kv, k_pe, q_a_g, w_uq, kv_a_g, w_ukv, cos, sin):
    B, S, _ = c_q.shape
    q = (rmsnorm(c_q, q_a_g) @ w_uq).reshape(B, S, MLA_HEADS, QK_DIM)
    q_nope, q_pe = q[..., :QK_NOPE_DIM], q[..., QK_NOPE_DIM:]
    q_pe = apply_rope(q_pe, cos[:, :, None, :], sin[:, :, None, :])
    kv = (rmsnorm(c_kv, kv_a_g) @ w_ukv).reshape(B, S, MLA_HEADS, QK_NOPE_DIM + V_HEAD_DIM)
    k_nope, v = kv[..., :QK_NOPE_DIM], kv[..., QK_NOPE_DIM:]
    k_pe = apply_rope(k_pe, cos, sin)
    q = jnp.concatenate([q_nope, q_pe], axis=-1)
    k = jnp.concatenate(
        [k_nope, jnp.broadcast_to(k_pe[:, :, None, :], (B, S, MLA_HEADS, QK_ROPE_DIM))], axis=-1)
    scale = 1.0 / math.sqrt(QK_DIM)
    nb = S // Q_BLOCK
    q_blocks = q.reshape(B, nb, Q_BLOCK, MLA_HEADS, QK_DIM).transpose(1, 0, 2, 3, 4)
    key_pos = jnp.arange(S)

    def one_block(args):
        q_blk, i = args
        s = jnp.einsum('bqhd,bkhd->bhqk', q_blk, k,
                       preferred_element_type=jnp.float32) * scale
        q_pos = i * Q_BLOCK + jnp.arange(Q_BLOCK)
        s = jnp.where(key_pos[None, :] <= q_pos[:, None], s, NEG_INF)
        p = jax.nn.softmax(s, axis=-1).astype(v.dtype)
        return jnp.einsum('bhqk,bkhd->bqhd', p, v)

    o = lax.map(one_block, (q_blocks, jnp.arange(nb)))
    return o.transpose(1, 0, 2, 3, 4).reshape(B, S, MLA_WIDTH)


def rglru_group(u, gate, conv_w, conv_b, w_a, b_a, w_x, b_x, lam):
    B, S, W = u.shape
    u_pad = jnp.pad(u, ((0, 0), (CONV_WIDTH - 1, 0), (0, 0)))
    xc = conv_b
    for tap in range(CONV_WIDTH):
        xc = xc + u_pad[:, tap:tap + S] * conv_w[tap]
    xb = xc.reshape(B, S, LRU_BLOCKS, LRU_BLOCK_DIM)
    r = jax.nn.sigmoid(jnp.einsum('bsnd,nde->bsne', xb, w_a) + b_a).reshape(B, S, W)
    i = jax.nn.sigmoid(jnp.einsum('bsnd,nde->bsne', xb, w_x) + b_x).reshape(B, S, W)
    log_a = -LRU_C * r.astype(jnp.float32) * jax.nn.softplus(-lam.astype(jnp.float32))
    a = jnp.exp(log_a)
    b = jnp.sqrt(-jnp.expm1(2.0 * log_a)) * (i * xc).astype(jnp.float32)

    def combine(lhs, rhs):
        a1, b1 = lhs
        a2, b2 = rhs
        return a1 * a2, a2 * b1 + b2

    _, h = lax.associative_scan(combine, (a, b), axis=1)
    return h.astype(u.dtype) * jax.nn.gelu(gate)


def memory_xattn(h, mem_n, w_q, w_kv, w_o):
    B, S, _ = h.shape
    q = (h @ w_q).reshape(B, S, XA_HEADS, XA_HEAD_DIM)
    k, v = jnp.split(mem_n @ w_kv, 2, axis=-1)
    k = k.reshape(B, MEM_LEN, XA_HEADS, XA_HEAD_DIM)
    v = v.reshape(B, MEM_LEN, XA_HEADS, XA_HEAD_DIM)
    s = jnp.einsum('bshd,bmhd->bhsm', q, k,
                   preferred_element_type=jnp.float32) / math.sqrt(XA_HEAD_DIM)
    p = jax.nn.softmax(s, axis=-1).astype(v.dtype)
    o = jnp.einsum('bhsm,bmhd->bshd', p, v).reshape(B, S, XA_WIDTH)
    return o @ w_o


def setup_inputs(seed: int = 0) -> dict:
    key = jax.random.key(seed)
    ks = iter(jax.random.split(key, 40))
    f32 = jnp.float32

    def w(shape, fan_in):
        return jax.random.normal(next(ks), (DEPTH,) + shape, f32) * fan_in ** -0.5

    def gain(n):
        return 1.0 + 0.1 * jax.random.normal(next(ks), (DEPTH, n), f32)

    def bias(shape):
        return 0.01 * jax.random.normal(next(ks), (DEPTH,) + shape, f32)

    x = jax.random.normal(next(ks), (BATCH, SEQ, D_MODEL), f32)
    mem = jax.random.normal(next(ks), (BATCH, MEM_LEN, D_MODEL), f32)
    offset = jax.random.randint(next(ks), (BATCH, 1), 0, 1024, dtype=jnp.int32)
    positions = (jnp.arange(SEQ, dtype=jnp.int32)[None, :] + offset).astype(jnp.int32)
    u = jax.random.uniform(next(ks), (DEPTH, LRU_WIDTH), f32, 0.9, 0.999) ** (1.0 / LRU_C)
    rg_lambda = jnp.log(u) - jnp.log1p(-u)
    return {
        "x": x,
        "mem": mem,
        "positions": positions,
        "ffn1_pre_g": gain(D_MODEL),
        "ffn1_w_gu": w((D_MODEL, 2 * D_FF), D_MODEL),
        "ffn1_w_down": w((D_FF, D_MODEL), D_FF),
        "ffn1_post_g": gain(D_MODEL),
        "mix_pre_g": gain(D_MODEL),
        "w_in": w((D_MODEL, IN_COLS), D_MODEL),
        "q_a_norm_g": gain(Q_LORA_RANK),
        "w_uq": w((Q_LORA_RANK, MLA_HEADS * QK_DIM), Q_LORA_RANK),
        "kv_a_norm_g": gain(KV_LORA_RANK),
        "w_ukv": w((KV_LORA_RANK, MLA_HEADS * (QK_NOPE_DIM + V_HEAD_DIM)), KV_LORA_RANK),
        "conv_w": w((CONV_WIDTH, LRU_WIDTH), CONV_WIDTH),
        "conv_b": bias((LRU_WIDTH,)),
        "rg_w_a": w((LRU_BLOCKS, LRU_BLOCK_DIM, LRU_BLOCK_DIM), LRU_BLOCK_DIM),
        "rg_b_a": bias((LRU_BLOCKS, LRU_BLOCK_DIM)),
        "rg_w_x": w((LRU_BLOCKS, LRU_BLOCK_DIM, LRU_BLOCK_DIM), LRU_BLOCK_DIM),
        "rg_b_x": bias((LRU_BLOCKS, LRU_BLOCK_DIM)),
        "rg_lambda": rg_lambda,
        "w_out": w((D_MODEL, D_MODEL), D_MODEL),
        "mix_post_g": gain(D_MODEL),
        "xa_pre_g": gain(D_MODEL),
        "mem_norm_g": gain(D_MODEL),
        "xa_w_q": w((D_MODEL, XA_WIDTH), D_MODEL),
        "xa_w_kv": w((D_MODEL, 2 * XA_WIDTH), D_MODEL),
        "xa_w_o": w((XA_WIDTH, D_MODEL), XA_WIDTH),
        "xa_post_g": gain(D_MODEL),
        "ffn2_pre_g": gain(D_MODEL),
        "ffn2_w_gu": w((D_MODEL, 2 * D_FF), D_MODEL),
        "ffn2_w_down": w((D_FF, D_MODEL), D_FF),
        "ffn2_post_g": gain(D_MODEL),
    }


def reference(x, mem, positions, ffn1_pre_g, ffn1_w_gu, ffn1_w_down, ffn1_post_g,
              mix_pre_g, w_in, q_a_norm_g, w_uq, kv_a_norm_g, w_ukv, conv_w, conv_b,
              rg_w_a, rg_b_a, rg_w_x, rg_b_x, rg_lambda, w_out, mix_post_g,
              xa_pre_g, mem_norm_g, xa_w_q, xa_w_kv, xa_w_o, xa_post_g,
              ffn2_pre_g, ffn2_w_gu, ffn2_w_down, ffn2_post_g):
    cos, sin = rope_tables(positions)
    o1 = Q_LORA_RANK
    o2 = o1 + KV_LORA_RANK
    o3 = o2 + QK_ROPE_DIM
    o4 = o3 + LRU_WIDTH
    for l in range(DEPTH):
        h = rmsnorm(x, ffn1_pre_g[l])
        x = x + 0.5 * rmsnorm(swiglu(h, ffn1_w_gu[l], ffn1_w_down[l]), ffn1_post_g[l])

        h = rmsnorm(x, mix_pre_g[l])
        z = h @ w_in[l]
        c_q, c_kv, k_pe = z[..., :o1], z[..., o1:o2], z[..., o2:o3]
        u, gate = z[..., o3:o4], z[..., o4:]
        y_mla = mla(c_q, c_kv, k_pe, q_a_norm_g[l], w_uq[l], kv_a_norm_g[l], w_ukv[l], cos, sin)
        y_lru = rglru_group(u, gate, conv_w[l], conv_b[l], rg_w_a[l], rg_b_a[l],
                            rg_w_x[l], rg_b_x[l], rg_lambda[l])
        y = jnp.concatenate([y_mla, y_lru], axis=-1) @ w_out[l]
        x = x + rmsnorm(y, mix_post_g[l])

        h = rmsnorm(x, xa_pre_g[l])
        mem_n = rmsnorm(mem, mem_norm_g[l])
        y = memory_xattn(h, mem_n, xa_w_q[l], xa_w_kv[l], xa_w_o[l])
        x = x + rmsnorm(y, xa_post_g[l])

        h = rmsnorm(x, ffn2_pre_g[l])
        x = x + 0.5 * rmsnorm(swiglu(h, ffn2_w_gu[l], ffn2_w_down[l]), ffn2_post_g[l])
    return x
```

```cpp
#include <hip/hip_runtime.h>
#include <hip/hip_cooperative_groups.h>
#include <cstdio>
#include <cstdint>
namespace cg = cooperative_groups;

typedef unsigned short bf16_t;
typedef short bf16x8 __attribute__((ext_vector_type(8)));
typedef float f32x4 __attribute__((ext_vector_type(4)));
typedef float f32x16 __attribute__((ext_vector_type(16)));
typedef unsigned u32x2 __attribute__((ext_vector_type(2)));
typedef unsigned u32x4 __attribute__((ext_vector_type(4)));

constexpr int BATCH = 4, SEQ = 8192, T = BATCH * SEQ, DM = 1024, MEML = 256, MT = BATCH * MEML;
constexpr int NH = 4, DN = 128, DR = 64, DQK = 192, DV = 128, QLR = 384, KVLR = 256;
constexpr int LRUW = 512, NBLK = 8, BD = 64, INC = 1728, DFF = 2816;
constexpr int XAW = 512;
constexpr float EPS = 1e-6f;
constexpr int NTHREADS = 512, NWAVES = 8;
constexpr int LDS_BYTES = 147456;

constexpr size_t MiB = 1u << 20;
constexpr size_t WS_CTL = 0, CTL_ZERO_BYTES = 1 * MiB;
constexpr size_t WS_RS = 1 * MiB;
constexpr size_t WS_SSQQ = 2 * MiB;
constexpr size_t WS_SSQKV = 4 * MiB;
constexpr size_t WS_LRUSUM = 5 * MiB;
constexpr size_t WS_COS = 8 * MiB, WS_SIN = 12 * MiB;
constexpr size_t WS_W = 16 * MiB;
constexpr size_t WS_MEMN = 60 * MiB, WS_MEMKV = 62 * MiB;
constexpr size_t WS_XB = 64 * MiB;
constexpr size_t WS_HID = 128 * MiB;
constexpr size_t WS_CQ = 128 * MiB, WS_CKV = 152 * MiB, WS_KPER = 168 * MiB, WS_U = 172 * MiB, WS_GATE = 204 * MiB, WS_Q = 236 * MiB, WS_KPE = 284 * MiB;
constexpr size_t WS_KV = 304 * MiB, WS_QX = 304 * MiB, WS_OX = 336 * MiB;
constexpr size_t WS_YCAT = 368 * MiB;
constexpr size_t WS_LRUH = 432 * MiB, WS_LRUP = 464 * MiB;
constexpr size_t WS_YA = 304 * MiB, WS_YB = 128 * MiB;
constexpr size_t WS_END = 512 * MiB;

struct Params { const float* in[32]; float* out; unsigned char* ws; };
enum { I_X = 0, I_MEM, I_POS, I_F1PRE, I_F1GU, I_F1DN, I_F1POST, I_MIXPRE, I_WIN, I_QAG, I_WUQ, I_KVAG, I_WUKV, I_CONVW, I_CONVB,
       I_RGWA, I_RGBA, I_RGWX, I_RGBX, I_LAM, I_WOUT, I_MIXPOST, I_XAPRE, I_MEMG, I_XAWQ, I_XAWKV, I_XAWO, I_XAPOST, I_F2PRE, I_F2GU, I_F2DN, I_F2POST };

struct Ctx { int tid, lane, wave, gw, ngw, gt, ngt; };

__device__ __forceinline__ float bf2f(bf16_t v) { return __uint_as_float((unsigned)v << 16); }
__device__ __forceinline__ float bfs(short v) { return __uint_as_float(((unsigned)(unsigned short)v) << 16); }
__device__ __forceinline__ unsigned f2bf(float f) { unsigned u = __float_as_uint(f); return (u + 0x7fffu + ((u >> 16) & 1u)) >> 16; }
__device__ __forceinline__ unsigned pk2(float lo, float hi) { return f2bf(lo) | (f2bf(hi) << 16); }
__device__ __forceinline__ float wave_sum(float v) {
#pragma unroll
    for (int o = 1; o < 64; o <<= 1) v += __shfl_xor(v, o);
    return v;
}
__device__ __forceinline__ float wave_max(float v) {
#pragma unroll
    for (int o = 1; o < 64; o <<= 1) v = fmaxf(v, __shfl_xor(v, o));
    return v;
}
__device__ __forceinline__ float sigmoidf_(float x) { return 1.0f / (1.0f + __expf(-x)); }
__device__ __forceinline__ float siluf_(float x) { return x / (1.0f + __expf(-x)); }
__device__ __forceinline__ float gelu_tanh(float x) { const float u = 0.7978845608028654f * (x + 0.044715f * x * x * x); return 0.5f * x * (1.0f + tanhf(u)); }
__device__ __forceinline__ int crow(int r, int hi) { return (r & 3) + 8 * (r >> 2) + 4 * hi; }

template <bool PAIR, class RSF, class EPI>
__device__ __forceinline__ void ngemm(const bf16_t* A, int lda, const float* W, int ldw, const float* gk, int M, int N, int K, int pair_off,
                                      RSF rsf, EPI epi, const Ctx& c) {
    const int r = c.lane & 31, h = c.lane >> 5;
    const int ntn = N / 32, ntm = M / 64;
    for (int it = c.gw; it < ntm * ntn; it += c.ngw) {
        const int tn = it % ntn, tm = it / ntn;
        f32x16 a00 = {}, a10 = {}, a01 = {}, a11 = {};
        const bf16_t* a0 = A + (size_t)(tm * 64 + r) * lda + 8 * h;
        const bf16_t* a1 = a0 + (size_t)32 * lda;
        const float* w0 = W + (size_t)(8 * h) * ldw + tn * 32 + r;
        for (int k = 0; k < K; k += 16) {
            const bf16x8 fa0 = *(const bf16x8*)(a0 + k), fa1 = *(const bf16x8*)(a1 + k);
            bf16x8 fb, fb2;
#pragma unroll
            for (int j = 0; j < 8; ++j) {
                const float g = gk ? gk[k + 8 * h + j] : 1.0f;
                fb[j] = (short)f2bf(w0[(size_t)(k + j) * ldw] * g);
                if (PAIR) fb2[j] = (short)f2bf(w0[(size_t)(k + j) * ldw + pair_off] * g);
            }
            a00 = __builtin_amdgcn_mfma_f32_32x32x16_bf16(fa0, fb, a00, 0, 0, 0);
            a10 = __builtin_amdgcn_mfma_f32_32x32x16_bf16(fa1, fb, a10, 0, 0, 0);
            if (PAIR) {
                a01 = __builtin_amdgcn_mfma_f32_32x32x16_bf16(fa0, fb2, a01, 0, 0, 0);
                a11 = __builtin_amdgcn_mfma_f32_32x32x16_bf16(fa1, fb2, a11, 0, 0, 0);
            }
        }
        const int col = tn * 32 + r;
#pragma unroll
        for (int i = 0; i < 16; ++i) {
            const int row0 = tm * 64 + crow(i, h), row1 = row0 + 32;
            const float s0 = rsf(row0), s1 = rsf(row1);
            epi(row0, col, a00[i] * s0, a01[i] * s0);
            epi(row1, col, a10[i] * s1, a11[i] * s1);
        }
    }
}

__device__ __forceinline__ void nrow_prep(const float* x, bf16_t* xb, float* rs, int nrows, const Ctx& c) {
    for (int row = c.gw; row < nrows; row += c.ngw) {
        const f32x4* xr = (const f32x4*)(x + (size_t)row * DM) + c.lane;
        f32x4 v[4]; float ss = 0.f;
#pragma unroll
        for (int j = 0; j < 4; ++j) { v[j] = xr[64 * j]; ss += (v[j].x * v[j].x + v[j].y * v[j].y) + (v[j].z * v[j].z + v[j].w * v[j].w); }
        ss = wave_sum(ss);
        u32x2* o = (u32x2*)(xb + (size_t)row * DM) + c.lane;
#pragma unroll
        for (int j = 0; j < 4; ++j) { u32x2 w; w.x = pk2(v[j].x, v[j].y); w.y = pk2(v[j].z, v[j].w); o[64 * j] = w; }
        if (c.lane == 0) rs[row] = rsqrtf(ss * (1.0f / DM) + EPS);
    }
}
__device__ __forceinline__ void nrow_memn(const float* mem, const float* g, bf16_t* memn, const Ctx& c) {
    for (int row = c.gw; row < MT; row += c.ngw) {
        const f32x4* xr = (const f32x4*)(mem + (size_t)row * DM) + c.lane; const f32x4* gr = (const f32x4*)g + c.lane;
        f32x4 v[4]; float ss = 0.f;
#pragma unroll
        for (int j = 0; j < 4; ++j) { v[j] = xr[64 * j]; ss += (v[j].x * v[j].x + v[j].y * v[j].y) + (v[j].z * v[j].z + v[j].w * v[j].w); }
        const float rs = rsqrtf(wave_sum(ss) * (1.0f / DM) + EPS);
        u32x2* o = (u32x2*)(memn + (size_t)row * DM) + c.lane;
#pragma unroll
        for (int j = 0; j < 4; ++j) { const f32x4 gg = gr[64 * j]; u32x2 w; w.x = pk2(v[j].x * rs * gg.x, v[j].y * rs * gg.y); w.y = pk2(v[j].z * rs * gg.z, v[j].w * rs * gg.w); o[64 * j] = w; }
    }
}
__device__ __forceinline__ void nrope_tables(const int* pos, float* cosT, float* sinT, const Ctx& c) {
    for (int i = c.gt; i < T * 32; i += c.ngt) {
        const int row = i >> 5, k = i & 31;
        const float inv = (float)exp2(-(double)k * (13.287712379549449 / 32.0));
        const float ang = (float)pos[row] * inv;
        const double a = (double)ang; const double n = rint(a * 0.15915494309189535);
        const float rr = (float)((a - n * 6.283185307179586) - n * 2.4492935982947064e-16);
        cosT[i] = cosf(rr); sinT[i] = sinf(rr);
    }
}
__device__ __forceinline__ void nrow_resnorm(const float* base, const float* y, const float* g, float coef, float* xout, bf16_t* xb, float* rs_out, const Ctx& c) {
    for (int row = c.gw; row < T; row += c.ngw) {
        const f32x4* yr = (const f32x4*)(y + (size_t)row * DM) + c.lane; const f32x4* br = (const f32x4*)(base + (size_t)row * DM) + c.lane; const f32x4* gr = (const f32x4*)g + c.lane;
        f32x4 v[4]; float ss = 0.f;
#pragma unroll
        for (int j = 0; j < 4; ++j) { v[j] = yr[64 * j]; ss += (v[j].x * v[j].x + v[j].y * v[j].y) + (v[j].z * v[j].z + v[j].w * v[j].w); }
        const float rs = rsqrtf(wave_sum(ss) * (1.0f / DM) + EPS) * coef;
        float s2 = 0.f;
#pragma unroll
        for (int j = 0; j < 4; ++j) { const f32x4 gg = gr[64 * j], bb = br[64 * j]; v[j] = bb + v[j] * rs * gg; s2 += (v[j].x * v[j].x + v[j].y * v[j].y) + (v[j].z * v[j].z + v[j].w * v[j].w); }
        s2 = wave_sum(s2);
        f32x4* xo = (f32x4*)(xout + (size_t)row * DM) + c.lane; u32x2* o = (u32x2*)(xb + (size_t)row * DM) + c.lane;
#pragma unroll
        for (int j = 0; j < 4; ++j) { xo[64 * j] = v[j]; u32x2 w; w.x = pk2(v[j].x, v[j].y); w.y = pk2(v[j].z, v[j].w); o[64 * j] = w; }
        if (c.lane == 0) rs_out[row] = rsqrtf(s2 * (1.0f / DM) + EPS);
    }
}
__device__ __forceinline__ void nrow_ssq(const bf16_t* cq, const bf16_t* ckv, float* ssq_q, float* ssq_kv, const Ctx& c) {
    for (int row = c.gw; row < T; row += c.ngw) {
        float s = 0.f;
        for (int d = c.lane; d < QLR; d += 64) { const float v = bf2f(cq[(size_t)row * QLR + d]); s += v * v; }
        s = wave_sum(s);
        float s2 = 0.f;
        for (int d = c.lane; d < KVLR; d += 64) { const float v = bf2f(ckv[(size_t)row * KVLR + d]); s2 += v * v; }
        s2 = wave_sum(s2);
        if (c.lane < 12) ssq_q[(size_t)row * 12 + c.lane] = c.lane == 0 ? s : 0.f;
        if (c.lane < 8) ssq_kv[(size_t)row * 8 + c.lane] = c.lane == 0 ? s2 : 0.f;
    }
}
__device__ __forceinline__ void nrope_apply(bf16_t* Q, const bf16_t* kper, bf16_t* kpe, const float* cosT, const float* sinT, const Ctx& c) {
    for (int i = c.gt; i < T * 5 * 32; i += c.ngt) {
        const int k = i & 31, hh = (i >> 5) % 5, row = i / 160;
        const float cs = cosT[row * 32 + k], sn = sinT[row * 32 + k];
        if (hh < 4) { bf16_t* q = Q + (size_t)row * 768 + hh * DQK + DN; const float x1 = bf2f(q[k]), x2 = bf2f(q[k + 32]);
            q[k] = (bf16_t)f2bf(x1 * cs - x2 * sn); q[k + 32] = (bf16_t)f2bf(x2 * cs + x1 * sn); }
        else { const bf16_t* s = kper + (size_t)row * 64; const float x1 = bf2f(s[k]), x2 = bf2f(s[k + 32]);
            bf16_t* o = kpe + (size_t)row * 64; o[k] = (bf16_t)f2bf(x1 * cs - x2 * sn); o[k + 32] = (bf16_t)f2bf(x2 * cs + x1 * sn); }
    }
}

struct AttnDesc { const bf16_t* Q; int ldq, qhs; const bf16_t* K; int ldk, khs; const bf16_t* Kpe; const bf16_t* V; int ldv, vhs; bf16_t* O; int ldo, ohs; int SQ, SK; float scale; };
template <bool CAUSAL, bool PE>
__device__ __forceinline__ void nattn(const AttnDesc& d, const Ctx& c, float* wl  ) {
    constexpr int DQ = PE ? DQK : DN;
    const int nitems = BATCH * NH * d.SQ;
    float* qs = wl; float* pw = wl + 192;
    for (int it = c.gw; it < nitems; it += c.ngw) {
        const int i = it % d.SQ, bh = it / d.SQ, h = bh % NH, b = bh / NH;
        const bf16_t* qrow = d.Q + (size_t)(b * d.SQ + i) * d.ldq + h * d.qhs;
        asm volatile("s_waitcnt lgkmcnt(0)" ::: "memory");
        for (int dd = c.lane; dd < DQ; dd += 64) qs[dd] = bf2f(qrow[dd]) * d.scale;
        asm volatile("s_waitcnt lgkmcnt(0)" ::: "memory");
        const int nk = CAUSAL ? i + 1 : d.SK;
        float m = -1e30f, l = 0.f, o0 = 0.f, o1 = 0.f;
        for (int t0 = 0; t0 < nk; t0 += 64) {
            const int j = t0 + c.lane; const bool valid = j < nk; const int jj = valid ? j : nk - 1;
            const bf16_t* kr = d.K + (size_t)(b * d.SK + jj) * d.ldk + h * d.khs;
            float s = 0.f;
#pragma unroll 4
            for (int cc = 0; cc < 16; ++cc) { const bf16x8 kv = *(const bf16x8*)(kr + cc * 8); const f32x4 q0 = *(const f32x4*)(qs + cc * 8), q1 = *(const f32x4*)(qs + cc * 8 + 4);
                s += bfs(kv[0]) * q0.x + bfs(kv[1]) * q0.y + bfs(kv[2]) * q0.z + bfs(kv[3]) * q0.w + bfs(kv[4]) * q1.x + bfs(kv[5]) * q1.y + bfs(kv[6]) * q1.z + bfs(kv[7]) * q1.w; }
            if (PE) { const bf16_t* kp = d.Kpe + (size_t)(b * d.SK + jj) * DR;
#pragma unroll 4
                for (int cc = 0; cc < 8; ++cc) { const bf16x8 kv = *(const bf16x8*)(kp + cc * 8); const f32x4 q0 = *(const f32x4*)(qs + DN + cc * 8), q1 = *(const f32x4*)(qs + DN + cc * 8 + 4);
                    s += bfs(kv[0]) * q0.x + bfs(kv[1]) * q0.y + bfs(kv[2]) * q0.z + bfs(kv[3]) * q0.w + bfs(kv[4]) * q1.x + bfs(kv[5]) * q1.y + bfs(kv[6]) * q1.z + bfs(kv[7]) * q1.w; } }
            if (!valid) s = -__builtin_inff();
            const float mn = fmaxf(m, wave_max(s));
            const float alpha = __expf(m - mn);
            const float pj = valid ? __expf(s - mn) : 0.f;
            l = l * alpha + wave_sum(pj); o0 *= alpha; o1 *= alpha; m = mn;
            asm volatile("s_waitcnt lgkmcnt(0)" ::: "memory");
            pw[c.lane] = pj;
            asm volatile("s_waitcnt lgkmcnt(0)" ::: "memory");
            const int cnt = (nk - t0) < 64 ? (nk - t0) : 64;
            const bf16_t* vr = d.V + (size_t)(b * d.SK + t0) * d.ldv + h * d.vhs + c.lane;
            for (int e = 0; e < cnt; ++e) { const float pe = pw[e]; o0 += pe * bf2f(vr[(size_t)e * d.ldv]); o1 += pe * bf2f(vr[(size_t)e * d.ldv + 64]); }
        }
        const float il = 1.0f / l;
        bf16_t* orow = d.O + (size_t)(b * d.SQ + i) * d.ldo + h * d.ohs;
        orow[c.lane] = (bf16_t)f2bf(o0 * il); orow[c.lane + 64] = (bf16_t)f2bf(o1 * il);
    }
}

__device__ __forceinline__ void nlru(const bf16_t* U, const bf16_t* G, const float* conv_w, const float* conv_b, const float* w_a, const float* b_a,
                                     const float* w_x, const float* b_x, const float* lam, bf16_t* ycat, int item, int lane) {
    const int b = item / NBLK, n = item % NBLK, ch = n * BD + lane;
    float wa[64], wx[64];
#pragma unroll
    for (int dd = 0; dd < 64; ++dd) { wa[dd] = w_a[(size_t)(n * 64 + dd) * 64 + lane]; wx[dd] = w_x[(size_t)(n * 64 + dd) * 64 + lane]; }
    const float cw0 = conv_w[ch], cw1 = conv_w[LRUW + ch], cw2 = conv_w[2 * LRUW + ch], cw3 = conv_w[3 * LRUW + ch], cb = conv_b[ch];
    const float ba = b_a[n * 64 + lane], bx = b_x[n * 64 + lane];
    const float sp = log1pf(expf(-lam[ch]));
    float u3 = 0.f, u2 = 0.f, u1 = 0.f, hst = 0.f;
    for (int t = 0; t < SEQ; ++t) {
        const size_t row = (size_t)b * SEQ + t;
        const float u0 = bf2f(U[row * LRUW + ch]);
        const float xc = cb + cw0 * u3 + cw1 * u2 + cw2 * u1 + cw3 * u0;
        float ra = ba, ri = bx;
#pragma unroll
        for (int dd = 0; dd < 64; ++dd) { const float xd = __shfl(xc, dd); ra += xd * wa[dd]; ri += xd * wx[dd]; }
        const float rg = sigmoidf_(ra), ig = sigmoidf_(ri);
        const float log_a = -8.0f * rg * sp;
        const float a = expf(log_a);
        const float bb = sqrtf(-expm1f(2.0f * log_a)) * (ig * xc);
        hst = a * hst + bb;
        const float gt = bf2f(G[row * LRUW + ch]);
        ycat[row * DM + LRUW + ch] = (bf16_t)f2bf(hst * gelu_tanh(gt));
        u3 = u2; u2 = u1; u1 = u0;
    }
}

__global__ void __launch_bounds__(NTHREADS, 2) fwd_kernel(Params p) {
    cg::grid_group grid = cg::this_grid();
    extern __shared__ __attribute__((aligned(16))) unsigned char lds[];
    Ctx c; c.tid = threadIdx.x; c.lane = c.tid & 63; c.wave = __builtin_amdgcn_readfirstlane(c.tid >> 6);
    c.gw = blockIdx.x * NWAVES + c.wave; c.ngw = gridDim.x * NWAVES; c.gt = blockIdx.x * NTHREADS + c.tid; c.ngt = gridDim.x * NTHREADS;
    unsigned char* ws = p.ws;
    float* rs0 = (float*)(ws + WS_RS); float* rs1 = rs0 + T; float* rs2 = rs1 + T; float* rs3 = rs2 + T;
    float* ssq_q = (float*)(ws + WS_SSQQ); float* ssq_kv = (float*)(ws + WS_SSQKV);
    float* cosT = (float*)(ws + WS_COS); float* sinT = (float*)(ws + WS_SIN);
    bf16_t* memn = (bf16_t*)(ws + WS_MEMN); bf16_t* memkv = (bf16_t*)(ws + WS_MEMKV);
    bf16_t* xb = (bf16_t*)(ws + WS_XB); bf16_t* hid = (bf16_t*)(ws + WS_HID);
    bf16_t* cq = (bf16_t*)(ws + WS_CQ); bf16_t* ckv = (bf16_t*)(ws + WS_CKV); bf16_t* kper = (bf16_t*)(ws + WS_KPER); bf16_t* ub = (bf16_t*)(ws + WS_U); bf16_t* gateb = (bf16_t*)(ws + WS_GATE);
    bf16_t* Qb = (bf16_t*)(ws + WS_Q); bf16_t* kpe = (bf16_t*)(ws + WS_KPE); bf16_t* KVb = (bf16_t*)(ws + WS_KV);
    bf16_t* qx = (bf16_t*)(ws + WS_QX); bf16_t* ox = (bf16_t*)(ws + WS_OX); bf16_t* ycat = (bf16_t*)(ws + WS_YCAT);
    float* YA = (float*)(ws + WS_YA); float* YB = (float*)(ws + WS_YB);
    float* wl = (float*)lds + c.wave * 256;
    auto one = [](int) { return 1.0f; };

    nrow_prep(p.in[I_X], xb, rs0, T, c);
    nrow_memn(p.in[I_MEM], p.in[I_MEMG], memn, c);
    nrope_tables((const int*)p.in[I_POS], cosT, sinT, c);
    grid.sync();
    ngemm<true>(xb, DM, p.in[I_F1GU], 2 * DFF, p.in[I_F1PRE], T, DFF, DM, DFF, [=](int r) { return rs0[r]; },
                [=](int r, int col, float g, float u) { hid[(size_t)r * DFF + col] = (bf16_t)f2bf(siluf_(g) * u); }, c);
    grid.sync();
    ngemm<false>(hid, DFF, p.in[I_F1DN], DM, nullptr, T, DM, DFF, 0, one, [=](int r, int col, float v, float) { YA[(size_t)r * DM + col] = v; }, c);
    grid.sync();
    nrow_resnorm(p.in[I_X], YA, p.in[I_F1POST], 0.5f, p.out, xb, rs1, c);
    grid.sync();
    ngemm<false>(xb, DM, p.in[I_WIN], INC, p.in[I_MIXPRE], T, INC, DM, 0, [=](int r) { return rs1[r]; },
                 [=](int r, int col, float v, float) {
                     const bf16_t o = (bf16_t)f2bf(v);
                     if (col < 384) cq[(size_t)r * QLR + col] = o; else if (col < 640) ckv[(size_t)r * KVLR + col - 384] = o; else if (col < 704) kper[(size_t)r * DR + col - 640] = o;
                     else if (col < 1216) ub[(size_t)r * LRUW + col - 704] = o; else gateb[(size_t)r * LRUW + col - 1216] = o; }, c);
    grid.sync();
    nrow_ssq(cq, ckv, ssq_q, ssq_kv, c);
    grid.sync();
    ngemm<false>(cq, QLR, p.in[I_WUQ], NH * DQK, p.in[I_QAG], T, NH * DQK, QLR, 0,
                 [=](int r) { float s = 0.f; for (int k = 0; k < 12; ++k) s += ssq_q[(size_t)r * 12 + k]; return rsqrtf(s * (1.0f / QLR) + EPS); },
                 [=](int r, int col, float v, float) { Qb[(size_t)r * 768 + col] = (bf16_t)f2bf(v); }, c);
    ngemm<false>(ckv, KVLR, p.in[I_WUKV], NH * 256, p.in[I_KVAG], T, NH * 256, KVLR, 0,
                 [=](int r) { float s = 0.f; for (int k = 0; k < 8; ++k) s += ssq_kv[(size_t)r * 8 + k]; return rsqrtf(s * (1.0f / KVLR) + EPS); },
                 [=](int r, int col, float v, float) { KVb[(size_t)r * 1024 + col] = (bf16_t)f2bf(v); }, c);
    grid.sync();
    nrope_apply(Qb, kper, kpe, cosT, sinT, c);
    grid.sync();
    if (c.wave == 0 && blockIdx.x < 32)
        nlru(ub, gateb, p.in[I_CONVW], p.in[I_CONVB], p.in[I_RGWA], p.in[I_RGBA], p.in[I_RGWX], p.in[I_RGBX], p.in[I_LAM], ycat, blockIdx.x, c.lane);
    { AttnDesc d{Qb, 768, DQK, KVb, 1024, 256, kpe, KVb + DN, 1024, 256, ycat, DM, DV, SEQ, SEQ, 0.07216878364870322f};
      nattn<true, true>(d, c, wl); }
    grid.sync();
    ngemm<false>(ycat, DM, p.in[I_WOUT], DM, nullptr, T, DM, DM, 0, one, [=](int r, int col, float v, float) { YB[(size_t)r * DM + col] = v; }, c);
    grid.sync();
    nrow_resnorm(p.out, YB, p.in[I_MIXPOST], 1.0f, p.out, xb, rs2, c);
    grid.sync();
    ngemm<false>(xb, DM, p.in[I_XAWQ], XAW, p.in[I_XAPRE], T, XAW, DM, 0, [=](int r) { return rs2[r]; },
                 [=](int r, int col, float v, float) { qx[(size_t)r * XAW + col] = (bf16_t)f2bf(v); }, c);
    ngemm<false>(memn, DM, p.in[I_XAWKV], 2 * XAW, nullptr, MT, 2 * XAW, DM, 0, one,
                 [=](int r, int col, float v, float) { memkv[(size_t)r * 1024 + col] = (bf16_t)f2bf(v); }, c);
    grid.sync();
    { AttnDesc d{qx, XAW, 128, memkv, 1024, 128, nullptr, memkv + XAW, 1024, 128, ox, XAW, 128, SEQ, MEML, 0.08838834764831845f};
      nattn<false, false>(d, c, wl); }
    grid.sync();
    ngemm<false>(ox, XAW, p.in[I_XAWO], DM, nullptr, T, DM, XAW, 0, one, [=](int r, int col, float v, float) { YB[(size_t)r * DM + col] = v; }, c);
    grid.sync();
    nrow_resnorm(p.out, YB, p.in[I_XAPOST], 1.0f, p.out, xb, rs3, c);
    grid.sync();
    ngemm<true>(xb, DM, p.in[I_F2GU], 2 * DFF, p.in[I_F2PRE], T, DFF, DM, DFF, [=](int r) { return rs3[r]; },
                [=](int r, int col, float g, float u) { hid[(size_t)r * DFF + col] = (bf16_t)f2bf(siluf_(g) * u); }, c);
    grid.sync();
    ngemm<false>(hid, DFF, p.in[I_F2DN], DM, nullptr, T, DM, DFF, 0, one, [=](int r, int col, float v, float) { YA[(size_t)r * DM + col] = v; }, c);
    grid.sync();
    nrow_resnorm(p.out, YA, p.in[I_F2POST], 0.5f, p.out, xb, rs0, c);
}

extern "C" void kernel_launch(void* const* d_in, const int* in_sizes, int n_in, void* d_out, int out_size, void* d_ws, size_t ws_size, hipStream_t stream) {
    static int grid_blocks = 0;
    if (grid_blocks == 0) {
        if (n_in != 32 || out_size != T * DM || ws_size < WS_END) { fprintf(stderr, "kernel_launch: unexpected shapes (n_in %d out %d ws %zu)\n", n_in, out_size, ws_size); grid_blocks = -1; return; }
        int dev = 0, cus = 0, per_cu = 0;
        (void)hipGetDevice(&dev);
        (void)hipDeviceGetAttribute(&cus, hipDeviceAttributeMultiprocessorCount, dev);
        (void)hipFuncSetAttribute((const void*)fwd_kernel, hipFuncAttributeMaxDynamicSharedMemorySize, LDS_BYTES);
        (void)hipOccupancyMaxActiveBlocksPerMultiprocessor(&per_cu, (const void*)fwd_kernel, NTHREADS, LDS_BYTES);
        if (per_cu < 1) { fprintf(stderr, "kernel_launch: occupancy query says %d blocks per CU\n", per_cu); per_cu = 1; }
        if (per_cu > 1) per_cu = 1;
        grid_blocks = cus * per_cu;
        (void)hipGetLastError();
    }
    if (grid_blocks < 0) return;
    (void)hipMemsetAsync((char*)d_ws + WS_CTL, 0, CTL_ZERO_BYTES, stream);
    Params p{};
    for (int i = 0; i < 32; ++i) p.in[i] = (const float*)d_in[i];
    p.out = (float*)d_out; p.ws = (unsigned char*)d_ws;
    void* args[] = {&p};
    hipError_t e = hipLaunchCooperativeKernel((const void*)fwd_kernel, dim3(grid_blocks), dim3(NTHREADS), args, LDS_BYTES, stream);
    if (e != hipSuccess) fprintf(stderr, "cooperative launch failed: %s (grid %d)\n", hipGetErrorString(e), grid_blocks);
}
```

```cpp
#include <hip/hip_runtime.h>
#include <hip/hip_cooperative_groups.h>
#include <cstdio>
#include <cstdint>
namespace cg = cooperative_groups;

typedef unsigned short bf16_t;
typedef short bf16x8 __attribute__((ext_vector_type(8)));
typedef float f32x4 __attribute__((ext_vector_type(4)));
typedef float f32x16 __attribute__((ext_vector_type(16)));
typedef unsigned u32x2 __attribute__((ext_vector_type(2)));
typedef unsigned u32x4 __attribute__((ext_vector_type(4)));

constexpr int BATCH = 4, SEQ = 8192, T = BATCH * SEQ, DM = 1024, MEML = 256, MT = BATCH * MEML;
constexpr int NH = 4, DN = 128, DR = 64, DQK = 192, DV = 128, QLR = 384, KVLR = 256;
constexpr int LRUW = 512, NBLK = 8, BD = 64, INC = 1728, DFF = 2816;
constexpr int XAW = 512;
constexpr float EPS = 1e-6f;
constexpr int NTHREADS = 512, NWAVES = 8;
constexpr int LDS_BYTES = 147456;

constexpr size_t MiB = 1u << 20;
constexpr size_t WS_CTL = 0, CTL_ZERO_BYTES = 1 * MiB;
constexpr size_t WS_RS = 1 * MiB;
constexpr size_t WS_SSQQ = 2 * MiB;
constexpr size_t WS_SSQKV = 4 * MiB;
constexpr size_t WS_LRUSUM = 5 * MiB;
constexpr size_t WS_COS = 8 * MiB, WS_SIN = 12 * MiB;
constexpr size_t WS_W = 16 * MiB;
constexpr size_t WS_MEMN = 60 * MiB, WS_MEMKV = 62 * MiB;
constexpr size_t WS_XB = 64 * MiB;
constexpr size_t WS_HID = 128 * MiB;
constexpr size_t WS_CQ = 128 * MiB, WS_CKV = 152 * MiB, WS_KPER = 168 * MiB, WS_U = 172 * MiB, WS_GATE = 204 * MiB, WS_Q = 236 * MiB, WS_KPE = 284 * MiB;
constexpr size_t WS_KV = 304 * MiB, WS_QX = 304 * MiB, WS_OX = 336 * MiB;
constexpr size_t WS_YCAT = 368 * MiB;
constexpr size_t WS_LRUH = 432 * MiB, WS_LRUP = 464 * MiB;
constexpr size_t WS_YA = 304 * MiB, WS_YB = 128 * MiB;
constexpr size_t WS_END = 512 * MiB;

struct Params { const float* in[32]; float* out; unsigned char* ws; };
enum { I_X = 0, I_MEM, I_POS, I_F1PRE, I_F1GU, I_F1DN, I_F1POST, I_MIXPRE, I_WIN, I_QAG, I_WUQ, I_KVAG, I_WUKV, I_CONVW, I_CONVB,
       I_RGWA, I_RGBA, I_RGWX, I_RGBX, I_LAM, I_WOUT, I_MIXPOST, I_XAPRE, I_MEMG, I_XAWQ, I_XAWKV, I_XAWO, I_XAPOST, I_F2PRE, I_F2GU, I_F2DN, I_F2POST };

struct Ctx { int tid, lane, wave, gw, ngw, gt, ngt; };

__device__ __forceinline__ float bf2f(bf16_t v) { return __uint_as_float((unsigned)v << 16); }
__device__ __forceinline__ float bfs(short v) { return __uint_as_float(((unsigned)(unsigned short)v) << 16); }
__device__ __forceinline__ unsigned f2bf(float f) { unsigned u = __float_as_uint(f); return (u + 0x7fffu + ((u >> 16) & 1u)) >> 16; }
__device__ __forceinline__ unsigned pk2(float lo, float hi) { return f2bf(lo) | (f2bf(hi) << 16); }
__device__ __forceinline__ float wave_sum(float v) {
#pragma unroll
    for (int o = 1; o < 64; o <<= 1) v += __shfl_xor(v, o);
    return v;
}
__device__ __forceinline__ float wave_max(float v) {
#pragma unroll
    for (int o = 1; o < 64; o <<= 1) v = fmaxf(v, __shfl_xor(v, o));
    return v;
}
__device__ __forceinline__ float sigmoidf_(float x) { return 1.0f / (1.0f + __expf(-x)); }
__device__ __forceinline__ float siluf_(float x) { return x / (1.0f + __expf(-x)); }
__device__ __forceinline__ float gelu_tanh(float x) { const float u = 0.7978845608028654f * (x + 0.044715f * x * x * x); return 0.5f * x * (1.0f + tanhf(u)); }
__device__ __forceinline__ int crow(int r, int hi) { return (r & 3) + 8 * (r >> 2) + 4 * hi; }

namespace pg8 {
#define PG8_LAS __attribute__((address_space(3)))
typedef unsigned short bf16_t;
typedef short bf16x8 __attribute__((ext_vector_type(8)));
typedef float f32x4 __attribute__((ext_vector_type(4)));
typedef unsigned u32x4 __attribute__((ext_vector_type(4)));
constexpr int BM = 256, BK = 64, HALF = 128, HTB = HALF * BK * 2  , STAGE_BYTES = 8 * HTB, NXCD = 8, WGM = 8;

__host__ __device__ __forceinline__ int lds_byte(int r, int c) { const int st = (r >> 4) * 2 + (c >> 5), rr = r & 15, cc = c & 31, ob = rr * 64 + cc * 2; return st * 1024 + (ob ^ (((ob >> 9) & 1) << 5)); }
__host__ __device__ __forceinline__ void stage_rc(int b, int& R, int& C) { const int st = b / 1024, sb = b % 1024, swz = sb ^ (((sb >> 9) & 1) << 5); R = (st >> 1) * 16 + swz / 64; C = (st & 1) * 32 + (swz % 64) / 2; }
__host__ __device__ __forceinline__ int perm32(int rho) { const int n = rho >> 4, i = rho & 15; return 8 * (i >> 2) + 4 * n + (i & 3); }

struct Unit { int pm, pn; };
struct Gemm { const bf16_t* A; const bf16_t* Bt; int M, N, K; };

struct StaticOrder {
    int nM, nN, nwg, G, c;
    __host__ __device__ void init(int M, int N, int G_, int c_) { nM = M / BM; nN = N / BM; nwg = nM * nN; G = G_; c = c_; }
    __host__ __device__ bool next(int i, Unit& u) const {
        const long L = (long)i * G + c; if (L >= nwg) return false;
        int wgid = (int)L; { const int q = nwg / NXCD, r = nwg % NXCD, xcd = wgid % NXCD, off = wgid / NXCD; wgid = (xcd < r ? xcd * (q + 1) : r * (q + 1) + (xcd - r) * q) + off; }
        const int nig = WGM * nN, gid = wgid / nig, fm = gid * WGM, gsz = (nM - fm) < WGM ? (nM - fm) : WGM;
        u.pm = fm + ((wgid % nig) % gsz); u.pn = (wgid % nig) / gsz; return true;
    }
    __device__ __forceinline__ void a_ready(const Unit&) const {}
    __device__ __forceinline__ void done(const Unit&) const {}
};

__device__ __forceinline__ unsigned cvt_pk_bf16(float lo, float hi) { unsigned r; asm volatile("v_cvt_pk_bf16_f32 %0, %1, %2" : "=v"(r) : "v"(lo), "v"(hi)); return r; }
typedef float f32x2 __attribute__((ext_vector_type(2)));

__device__ __forceinline__ u32x4 pack8s(f32x4 a, f32x4 b, float s) { u32x4 w; w.x = cvt_pk_bf16(a[0] * s, a[1] * s); w.y = cvt_pk_bf16(a[2] * s, a[3] * s); w.z = cvt_pk_bf16(b[0] * s, b[1] * s); w.w = cvt_pk_bf16(b[2] * s, b[3] * s); return w; }
__device__ __forceinline__ float silu_f(float x) { return x * __builtin_amdgcn_rcpf(1.0f + __expf(-x)); }

struct EpiF32 {
    static constexpr bool PERM = false, AFTER_DRAIN = false;
    float* C; int ldc;
    __device__ __forceinline__ void operator()(const f32x4 (&acc)[2][2][4][2], const Unit& u, int wr, int wc, int fr, int fq) const {
        const int row0 = u.pm * BM + wr * 64 + fr, col0 = u.pn * BM + wc * 32 + 4 * fq;
#pragma unroll
        for (int ai = 0; ai < 2; ++ai)
#pragma unroll
            for (int m = 0; m < 4; ++m) { float* rowp = C + (size_t)(row0 + ai * HALF + m * 16) * ldc + col0;
#pragma unroll
                for (int bj = 0; bj < 2; ++bj)
#pragma unroll
                    for (int n = 0; n < 2; ++n) *(f32x4*)(rowp + bj * HALF + n * 16) = acc[ai][bj][m][n]; }
    }
};
struct EpiSwiGLU {
    static constexpr bool PERM = true, AFTER_DRAIN = false;
    bf16_t* H; int ldh; const float* rs;
    __device__ __forceinline__ void operator()(const f32x4 (&acc)[2][2][4][2], const Unit& u, int wr, int wc, int fr, int fq) const {
        const int row0 = u.pm * BM + wr * 64 + fr, col0 = u.pn * HALF + wc * 32 + 8 * fq;
#pragma unroll
        for (int ai = 0; ai < 2; ++ai)
#pragma unroll
            for (int m = 0; m < 4; ++m) { const int row = row0 + ai * HALF + m * 16; const float s = rs[row];
                float h[8];
#pragma unroll
                for (int n = 0; n < 2; ++n)
#pragma unroll
                    for (int e = 0; e < 4; ++e) h[n * 4 + e] = silu_f(acc[ai][0][m][n][e] * s) * (acc[ai][1][m][n][e] * s);
                u32x4 w; w.x = cvt_pk_bf16(h[0], h[1]); w.y = cvt_pk_bf16(h[2], h[3]); w.z = cvt_pk_bf16(h[4], h[5]); w.w = cvt_pk_bf16(h[6], h[7]);
                *(u32x4*)(H + (size_t)row * ldh + col0) = w; }
    }
};
struct EpiRowScale {
    static constexpr bool PERM = true, AFTER_DRAIN = false;
    bf16_t* O; int ldc; int mode; const float* sc; int nslot; float inv_dim;
    __device__ __forceinline__ void operator()(const f32x4 (&acc)[2][2][4][2], const Unit& u, int wr, int wc, int fr, int fq) const {
        const int row0 = u.pm * BM + wr * 64 + fr, col0 = u.pn * BM + wc * 32 + 8 * fq;
#pragma unroll
        for (int ai = 0; ai < 2; ++ai)
#pragma unroll
            for (int m = 0; m < 4; ++m) { const int row = row0 + ai * HALF + m * 16; float s = 1.0f;
                if (mode == 1) s = sc[row];
                else if (mode == 2) { float t = 0.f; const f32x4* sp = (const f32x4*)(sc + (size_t)row * nslot);
                    for (int k = 0; k < nslot / 4; ++k) { const f32x4 q = sp[k]; t += (q[0] + q[1]) + (q[2] + q[3]); }
                    s = rsqrtf(t * inv_dim + EPS); }
                bf16_t* rowp = O + (size_t)row * ldc + col0;
#pragma unroll
                for (int bj = 0; bj < 2; ++bj) *(u32x4*)(rowp + bj * HALF) = pack8s(acc[ai][bj][m][0], acc[ai][bj][m][1], s); }
    }
};
struct EpiWin {
    static constexpr bool PERM = true, AFTER_DRAIN = false;
    bf16_t *cq, *ckv, *kper, *ub, *gate; const float* rs; float *ssq_q, *ssq_kv;
    __device__ __forceinline__ void operator()(const f32x4 (&acc)[2][2][4][2], const Unit& u, int wr, int wc, int fr, int fq) const {
        const int row0 = u.pm * BM + wr * 64 + fr, cl = wc * 32 + 8 * fq;
#pragma unroll
        for (int ai = 0; ai < 2; ++ai)
#pragma unroll
            for (int m = 0; m < 4; ++m) { const int row = row0 + ai * HALF + m * 16; const float s = rs[row];
#pragma unroll
                for (int bj = 0; bj < 2; ++bj) { const int hb = 2 * u.pn + bj;
                    const f32x4 v0 = acc[ai][bj][m][0] * s, v1 = acc[ai][bj][m][1] * s;
                    bf16_t* dst;
                    if (hb < 3) dst = cq + (size_t)row * 384 + hb * 128 + cl;
                    else if (hb < 5) dst = ckv + (size_t)row * 256 + (hb - 3) * 128 + cl;
                    else if (hb == 5) dst = (wc < 2) ? kper + (size_t)row * 64 + cl : nullptr;
                    else if (hb < 10) dst = ub + (size_t)row * 512 + (hb - 6) * 128 + cl;
                    else dst = gate + (size_t)row * 512 + (hb - 10) * 128 + cl;
                    if (dst) *(u32x4*)dst = pack8s(v0, v1, 1.0f);
                    if (hb < 5) { float q = (v0[0] * v0[0] + v0[1] * v0[1]) + (v0[2] * v0[2] + v0[3] * v0[3]) + (v1[0] * v1[0] + v1[1] * v1[1]) + (v1[2] * v1[2] + v1[3] * v1[3]);
                        q += __shfl_xor(q, 16); q += __shfl_xor(q, 32);
                        if (fq == 0) { if (hb < 3) ssq_q[(size_t)row * 12 + hb * 4 + wc] = q; else ssq_kv[(size_t)row * 8 + (hb - 3) * 4 + wc] = q; } } } }
    }
};
struct EpiQ {
    static constexpr bool PERM = true, AFTER_DRAIN = false;
    bf16_t* Q; const float* ssq; const float* cosT; const float* sinT;
    __device__ __forceinline__ void operator()(const f32x4 (&acc)[2][2][4][2], const Unit& u, int wr, int wc, int fr, int fq) const {
        const int row0 = u.pm * BM + wr * 64 + fr;
#pragma unroll
        for (int ai = 0; ai < 2; ++ai)
#pragma unroll
            for (int m = 0; m < 4; ++m) { const int row = row0 + ai * HALF + m * 16;
                const f32x4* sp = (const f32x4*)(ssq + (size_t)row * 12); const f32x4 q0 = sp[0], q1 = sp[1], q2 = sp[2];
                const float t = ((q0[0] + q0[1]) + (q0[2] + q0[3])) + ((q1[0] + q1[1]) + (q1[2] + q1[3])) + ((q2[0] + q2[1]) + (q2[2] + q2[3]));
                const float s = rsqrtf(t * (1.0f / 384.0f) + EPS);
                bf16_t* qrow = Q + (size_t)row * 768;
                if (u.pn < 2) {
#pragma unroll
                    for (int bj = 0; bj < 2; ++bj) *(u32x4*)(qrow + (2 * u.pn + bj) * 192 + wc * 32 + 8 * fq) = pack8s(acc[ai][bj][m][0], acc[ai][bj][m][1], s);
                } else {
                    const f32x4 c0 = *(const f32x4*)(cosT + (size_t)row * 32 + 8 * fq), c1 = *(const f32x4*)(cosT + (size_t)row * 32 + 8 * fq + 4);
                    const f32x4 s0 = *(const f32x4*)(sinT + (size_t)row * 32 + 8 * fq), s1 = *(const f32x4*)(sinT + (size_t)row * 32 + 8 * fq + 4);
                    const f32x4 xa0 = acc[ai][0][m][0] * s, xa1 = acc[ai][0][m][1] * s, xb0 = acc[ai][1][m][0] * s, xb1 = acc[ai][1][m][1] * s;
                    const f32x4 o10 = xa0 * c0 - xb0 * s0, o11 = xa1 * c1 - xb1 * s1, o20 = xb0 * c0 + xa0 * s0, o21 = xb1 * c1 + xa1 * s1;
                    *(u32x4*)(qrow + wc * 192 + 128 + 8 * fq) = pack8s(o10, o11, 1.0f);
                    *(u32x4*)(qrow + wc * 192 + 160 + 8 * fq) = pack8s(o20, o21, 1.0f);
                } }
    }
};
template <class Epi, class Sched, bool ALIGN_EPI = false, bool SP2 = false>
__device__ __forceinline__ void gemm_phase(PG8_LAS unsigned char* lds, const Gemm g, const Sched& S, const Epi& E) {
    const int tid = threadIdx.x, wid = __builtin_amdgcn_readfirstlane(tid >> 6), lane = tid & 63, wr = wid >> 2, wc = wid & 3, fr = lane & 15, fq = lane >> 4;
    int K = g.K; asm volatile("" : "+s"(K));
    const int nt = K / BK;
    unsigned voffA[2], voffB[2];
#pragma unroll
    for (int i = 0; i < 2; ++i) { int R, C; stage_rc(tid * 16 + i * 8192, R, C); const int Rb = Epi::PERM ? ((R & ~31) + perm32(R & 31)) : R;
        voffA[i] = (unsigned)(R * K + C) * 2u; voffB[i] = (unsigned)(Rb * K + C) * 2u; }
    const size_t kstep = (size_t)(BK * 2);
    const size_t hstep = (size_t)HALF * K * 2;
    const size_t tstep = 2 * hstep;
    const unsigned ldsw = (unsigned)wid * 1024u;
    const int aoff = lds_byte(wr * 64 + fr, fq * 8), boff = lds_byte(wc * 32 + fr, fq * 8);
#define PG8_SA(b, h) (((b) * 2 + (h)) * HTB)
#define PG8_SB(b, h) ((4 + (b) * 2 + (h)) * HTB)
#define PG8_STAGE(bufoff, gbase, voff) do { _Pragma("unroll") for (int _i = 0; _i < 2; ++_i) \
        __builtin_amdgcn_global_load_lds((const unsigned*)((const char*)(gbase) + (voff)[_i]), (PG8_LAS unsigned*)(lds + (bufoff) + ldsw + _i * 8192), 16, 0, 0); } while (0)
#define PG8_LDA(dst, b, h) do { _Pragma("unroll") for (int m = 0; m < 4; ++m) _Pragma("unroll") for (int k = 0; k < 2; ++k) dst[m][k] = *(const PG8_LAS bf16x8*)(lds + PG8_SA(b, h) + aoff + m * 2048 + k * 1024); } while (0)
#define PG8_LDB(dst, b, h) do { _Pragma("unroll") for (int n = 0; n < 2; ++n) _Pragma("unroll") for (int k = 0; k < 2; ++k) dst[n][k] = *(const PG8_LAS bf16x8*)(lds + PG8_SB(b, h) + boff + n * 2048 + k * 1024); } while (0)
#define PG8_MMA(ai, bj, At, Bt) do { __builtin_amdgcn_s_setprio(1); _Pragma("unroll") for (int m = 0; m < 4; ++m) _Pragma("unroll") for (int n = 0; n < 2; ++n) _Pragma("unroll") for (int k = 0; k < 2; ++k) \
        acc[ai][bj][m][n] = __builtin_amdgcn_mfma_f32_16x16x32_bf16(Bt[n][k], At[m][k], acc[ai][bj][m][n], 0, 0, 0); __builtin_amdgcn_s_setprio(0); } while (0)
#define PG8_WAIT_V(n) asm volatile("s_waitcnt vmcnt(" #n ")" ::: "memory")
#define PG8_WAIT_L(n) asm volatile("s_waitcnt lgkmcnt(" #n ")" ::: "memory")
#define PG8_BAR __builtin_amdgcn_s_barrier()
#define PG8_SCHED __builtin_amdgcn_sched_barrier(0)
    Unit cur, nxt; int ui = 0;
    if (!S.next(0, cur)) return;
    f32x4 acc[2][2][4][2];
#pragma unroll
    for (int a = 0; a < 2; ++a)
#pragma unroll
        for (int b = 0; b < 2; ++b)
#pragma unroll
            for (int m = 0; m < 4; ++m)
#pragma unroll
                for (int n = 0; n < 2; ++n) acc[a][b][m][n] = (f32x4){0.f, 0.f, 0.f, 0.f};
    bf16x8 At[4][2], B0[2][2], B1[2][2];
    const char* cA = (const char*)g.A + (size_t)cur.pm * tstep; const char* cB = (const char*)g.Bt + (size_t)cur.pn * tstep;
    S.a_ready(cur);
    if constexpr (SP2) {
        PG8_STAGE(PG8_SB(0, 0), cB, voffB); PG8_STAGE(PG8_SB(0, 1), cB + hstep, voffB); PG8_STAGE(PG8_SA(0, 0), cA, voffA); PG8_STAGE(PG8_SA(0, 1), cA + hstep, voffA);
        if (wr == 1) PG8_BAR;
        PG8_WAIT_V(2); PG8_BAR;
        PG8_STAGE(PG8_SB(1, 0), cB + kstep, voffB); PG8_STAGE(PG8_SA(1, 0), cA + kstep, voffA); PG8_STAGE(PG8_SB(1, 1), cB + hstep + kstep, voffB);
        PG8_WAIT_V(6); PG8_BAR;
    } else {
        PG8_STAGE(PG8_SB(0, 0), cB, voffB); PG8_STAGE(PG8_SA(0, 0), cA, voffA); PG8_STAGE(PG8_SB(0, 1), cB + hstep, voffB); PG8_STAGE(PG8_SA(0, 1), cA + hstep, voffA);
        if (wr == 1) PG8_BAR;
        PG8_WAIT_V(4); PG8_BAR;
        PG8_STAGE(PG8_SB(1, 0), cB + kstep, voffB); PG8_STAGE(PG8_SA(1, 0), cA + kstep, voffA); PG8_STAGE(PG8_SB(1, 1), cB + hstep + kstep, voffB);
        PG8_WAIT_V(6); PG8_BAR;
    }
    for (;;) {
        const bool has_next = S.next(ui + 1, nxt);
        const char* nA = has_next ? (const char*)g.A + (size_t)nxt.pm * tstep : cA; const char* nB = has_next ? (const char*)g.Bt + (size_t)nxt.pn * tstep : cB;
        for (int t = 0; t < nt; t += 2) {
            const bool last = (t == nt - 2);
            const char* a1 = cA + (size_t)(t + 1) * kstep;
            const char* a2 = last ? nA : cA + (size_t)(t + 2) * kstep; const char* b2 = last ? nB : cB + (size_t)(t + 2) * kstep;
            const char* a3 = a2 + kstep; const char* b3 = b2 + kstep;
            if (last && has_next) S.a_ready(nxt);
            if constexpr (SP2) {
            PG8_LDB(B0, 0, 0); PG8_LDB(B1, 0, 1); PG8_SCHED; PG8_LDA(At, 0, 0); PG8_STAGE(PG8_SA(1, 1), a1 + hstep, voffA);
            PG8_WAIT_V(8); PG8_WAIT_L(0); PG8_BAR; PG8_MMA(0, 0, At, B0); PG8_MMA(0, 1, At, B1); PG8_BAR; PG8_SCHED;
            PG8_LDA(At, 0, 1); PG8_STAGE(PG8_SB(0, 0), b2, voffB); PG8_STAGE(PG8_SB(0, 1), b2 + hstep, voffB); PG8_STAGE(PG8_SA(0, 0), a2, voffA);
            PG8_WAIT_V(8); PG8_WAIT_L(0); PG8_BAR; PG8_MMA(1, 0, At, B0); PG8_MMA(1, 1, At, B1); PG8_BAR; PG8_SCHED;
            PG8_LDB(B0, 1, 0); PG8_LDB(B1, 1, 1); PG8_SCHED; PG8_LDA(At, 1, 0); PG8_STAGE(PG8_SA(0, 1), a2 + hstep, voffA);
            PG8_WAIT_V(8); PG8_WAIT_L(0); PG8_BAR; PG8_MMA(0, 0, At, B0); PG8_MMA(0, 1, At, B1); PG8_BAR; PG8_SCHED;
            PG8_LDA(At, 1, 1); PG8_STAGE(PG8_SB(1, 0), b3, voffB); PG8_STAGE(PG8_SB(1, 1), b3 + hstep, voffB); PG8_STAGE(PG8_SA(1, 0), a3, voffA);
            PG8_WAIT_V(8); PG8_WAIT_L(0); PG8_BAR; PG8_MMA(1, 0, At, B0); PG8_MMA(1, 1, At, B1); PG8_BAR; PG8_SCHED;
            } else {
            PG8_LDB(B0, 0, 0); PG8_SCHED; PG8_LDA(At, 0, 0); PG8_STAGE(PG8_SA(1, 1), a1 + hstep, voffA);
            PG8_WAIT_L(8); PG8_BAR; PG8_WAIT_L(0); PG8_MMA(0, 0, At, B0); PG8_BAR; PG8_SCHED;
            PG8_LDB(B1, 0, 1); PG8_STAGE(PG8_SB(0, 0), b2, voffB);
            PG8_BAR; PG8_WAIT_L(0); PG8_MMA(0, 1, At, B1); PG8_BAR;
            PG8_LDA(At, 0, 1); PG8_STAGE(PG8_SA(0, 0), a2, voffA);
            PG8_BAR; PG8_WAIT_L(0); PG8_MMA(1, 0, At, B0); PG8_BAR; PG8_SCHED;
            PG8_STAGE(PG8_SB(0, 1), b2 + hstep, voffB);
            PG8_WAIT_V(6); PG8_BAR; PG8_MMA(1, 1, At, B1); PG8_BAR;
            PG8_LDB(B0, 1, 0); PG8_SCHED; PG8_LDA(At, 1, 0); PG8_STAGE(PG8_SA(0, 1), a2 + hstep, voffA);
            PG8_WAIT_L(8); PG8_BAR; PG8_WAIT_L(0); PG8_MMA(0, 0, At, B0); PG8_BAR; PG8_SCHED;
            PG8_LDB(B1, 1, 1); PG8_STAGE(PG8_SB(1, 0), b3, voffB);
            PG8_BAR; PG8_WAIT_L(0); PG8_MMA(0, 1, At, B1); PG8_BAR;
            PG8_LDA(At, 1, 1); PG8_STAGE(PG8_SA(1, 0), a3, voffA);
            PG8_BAR; PG8_WAIT_L(0); PG8_MMA(1, 0, At, B0); PG8_BAR; PG8_SCHED;
            PG8_STAGE(PG8_SB(1, 1), b3 + hstep, voffB);
            PG8_WAIT_V(6); PG8_BAR; PG8_MMA(1, 1, At, B1); PG8_BAR;
            }
        }
        if constexpr (ALIGN_EPI) { if (wr == 0) PG8_BAR; }
        if constexpr (!Epi::AFTER_DRAIN) { E(acc, cur, wr, wc, fr, fq); S.done(cur); }
        if (!has_next) break;
#pragma unroll
        for (int a = 0; a < 2; ++a)
#pragma unroll
            for (int b = 0; b < 2; ++b)
#pragma unroll
                for (int m = 0; m < 4; ++m)
#pragma unroll
                    for (int n = 0; n < 2; ++n) acc[a][b][m][n] = (f32x4){0.f, 0.f, 0.f, 0.f};
        cur = nxt; cA = nA; cB = nB; ++ui;
        if constexpr (ALIGN_EPI) { if (wr == 1) PG8_BAR; }
    }
    PG8_WAIT_V(0);
    if constexpr (!ALIGN_EPI) { if (wr == 0) PG8_BAR; }
    PG8_BAR;
    if constexpr (Epi::AFTER_DRAIN) { E.fused(acc, cur, wr, wc, fr, fq, lds, wid, lane); S.done(cur); }
#undef PG8_SA
#undef PG8_SB
#undef PG8_STAGE
#undef PG8_LDA
#undef PG8_LDB
#undef PG8_MMA
#undef PG8_WAIT_V
#undef PG8_WAIT_L
#undef PG8_BAR
#undef PG8_SCHED
}
}
template <bool PAIR, class RSF, class EPI>
__device__ __forceinline__ void ngemm(const bf16_t* A, int lda, const float* W, int ldw, const float* gk, int M, int N, int K, int pair_off,
                                      RSF rsf, EPI epi, const Ctx& c) {
    const int r = c.lane & 31, h = c.lane >> 5;
    const int ntn = N / 32, ntm = M / 64;
    for (int it = c.gw; it < ntm * ntn; it += c.ngw) {
        const int tn = it % ntn, tm = it / ntn;
        f32x16 a00 = {}, a10 = {}, a01 = {}, a11 = {};
        const bf16_t* a0 = A + (size_t)(tm * 64 + r) * lda + 8 * h;
        const bf16_t* a1 = a0 + (size_t)32 * lda;
        const float* w0 = W + (size_t)(8 * h) * ldw + tn * 32 + r;
        for (int k = 0; k < K; k += 16) {
            const bf16x8 fa0 = *(const bf16x8*)(a0 + k), fa1 = *(const bf16x8*)(a1 + k);
            bf16x8 fb, fb2;
#pragma unroll
            for (int j = 0; j < 8; ++j) {
                const float g = gk ? gk[k + 8 * h + j] : 1.0f;
                fb[j] = (short)f2bf(w0[(size_t)(k + j) * ldw] * g);
                if (PAIR) fb2[j] = (short)f2bf(w0[(size_t)(k + j) * ldw + pair_off] * g);
            }
            a00 = __builtin_amdgcn_mfma_f32_32x32x16_bf16(fa0, fb, a00, 0, 0, 0);
            a10 = __builtin_amdgcn_mfma_f32_32x32x16_bf16(fa1, fb, a10, 0, 0, 0);
            if (PAIR) {
                a01 = __builtin_amdgcn_mfma_f32_32x32x16_bf16(fa0, fb2, a01, 0, 0, 0);
                a11 = __builtin_amdgcn_mfma_f32_32x32x16_bf16(fa1, fb2, a11, 0, 0, 0);
            }
        }
        const int col = tn * 32 + r;
#pragma unroll
        for (int i = 0; i < 16; ++i) {
            const int row0 = tm * 64 + crow(i, h), row1 = row0 + 32;
            const float s0 = rsf(row0), s1 = rsf(row1);
            epi(row0, col, a00[i] * s0, a01[i] * s0);
            epi(row1, col, a10[i] * s1, a11[i] * s1);
        }
    }
}

__device__ __forceinline__ void nrow_prep(const float* x, bf16_t* xb, float* rs, int nrows, const Ctx& c) {
    for (int row = c.gw; row < nrows; row += c.ngw) {
        const f32x4* xr = (const f32x4*)(x + (size_t)row * DM) + c.lane;
        f32x4 v[4]; float ss = 0.f;
#pragma unroll
        for (int j = 0; j < 4; ++j) { v[j] = xr[64 * j]; ss += (v[j].x * v[j].x + v[j].y * v[j].y) + (v[j].z * v[j].z + v[j].w * v[j].w); }
        ss = wave_sum(ss);
        u32x2* o = (u32x2*)(xb + (size_t)row * DM) + c.lane;
#pragma unroll
        for (int j = 0; j < 4; ++j) { u32x2 w; w.x = pk2(v[j].x, v[j].y); w.y = pk2(v[j].z, v[j].w); o[64 * j] = w; }
        if (c.lane == 0) rs[row] = rsqrtf(ss * (1.0f / DM) + EPS);
    }
}
__device__ __forceinline__ void nrow_memn(const float* mem, const float* g, bf16_t* memn, const Ctx& c) {
    for (int row = c.gw; row < MT; row += c.ngw) {
        const f32x4* xr = (const f32x4*)(mem + (size_t)row * DM) + c.lane; const f32x4* gr = (const f32x4*)g + c.lane;
        f32x4 v[4]; float ss = 0.f;
#pragma unroll
        for (int j = 0; j < 4; ++j) { v[j] = xr[64 * j]; ss += (v[j].x * v[j].x + v[j].y * v[j].y) + (v[j].z * v[j].z + v[j].w * v[j].w); }
        const float rs = rsqrtf(wave_sum(ss) * (1.0f / DM) + EPS);
        u32x2* o = (u32x2*)(memn + (size_t)row * DM) + c.lane;
#pragma unroll
        for (int j = 0; j < 4; ++j) { const f32x4 gg = gr[64 * j]; u32x2 w; w.x = pk2(v[j].x * rs * gg.x, v[j].y * rs * gg.y); w.y = pk2(v[j].z * rs * gg.z, v[j].w * rs * gg.w); o[64 * j] = w; }
    }
}
__device__ __forceinline__ void nrope_tables(const int* pos, float* cosT, float* sinT, const Ctx& c) {
    for (int i = c.gt; i < T * 32; i += c.ngt) {
        const int row = i >> 5, k = i & 31;
        const float inv = (float)exp2(-(double)k * (13.287712379549449 / 32.0));
        const float ang = (float)pos[row] * inv;
        const double a = (double)ang; const double n = rint(a * 0.15915494309189535);
        const float rr = (float)((a - n * 6.283185307179586) - n * 2.4492935982947064e-16);
        cosT[i] = cosf(rr); sinT[i] = sinf(rr);
    }
}
__device__ __forceinline__ void nrow_resnorm(const float* base, const float* y, const float* g, float coef, float* xout, bf16_t* xb, float* rs_out, const Ctx& c) {
    for (int row = c.gw; row < T; row += c.ngw) {
        const f32x4* yr = (const f32x4*)(y + (size_t)row * DM) + c.lane; const f32x4* br = (const f32x4*)(base + (size_t)row * DM) + c.lane; const f32x4* gr = (const f32x4*)g + c.lane;
        f32x4 v[4]; float ss = 0.f;
#pragma unroll
        for (int j = 0; j < 4; ++j) { v[j] = yr[64 * j]; ss += (v[j].x * v[j].x + v[j].y * v[j].y) + (v[j].z * v[j].z + v[j].w * v[j].w); }
        const float rs = rsqrtf(wave_sum(ss) * (1.0f / DM) + EPS) * coef;
        float s2 = 0.f;
#pragma unroll
        for (int j = 0; j < 4; ++j) { const f32x4 gg = gr[64 * j], bb = br[64 * j]; v[j] = bb + v[j] * rs * gg; s2 += (v[j].x * v[j].x + v[j].y * v[j].y) + (v[j].z * v[j].z + v[j].w * v[j].w); }
        s2 = wave_sum(s2);
        f32x4* xo = (f32x4*)(xout + (size_t)row * DM) + c.lane; u32x2* o = (u32x2*)(xb + (size_t)row * DM) + c.lane;
#pragma unroll
        for (int j = 0; j < 4; ++j) { xo[64 * j] = v[j]; u32x2 w; w.x = pk2(v[j].x, v[j].y); w.y = pk2(v[j].z, v[j].w); o[64 * j] = w; }
        if (c.lane == 0) rs_out[row] = rsqrtf(s2 * (1.0f / DM) + EPS);
    }
}
__device__ __forceinline__ void nrow_ssq(const bf16_t* cq, const bf16_t* ckv, float* ssq_q, float* ssq_kv, const Ctx& c) {
    for (int row = c.gw; row < T; row += c.ngw) {
        float s = 0.f;
        for (int d = c.lane; d < QLR; d += 64) { const float v = bf2f(cq[(size_t)row * QLR + d]); s += v * v; }
        s = wave_sum(s);
        float s2 = 0.f;
        for (int d = c.lane; d < KVLR; d += 64) { const float v = bf2f(ckv[(size_t)row * KVLR + d]); s2 += v * v; }
        s2 = wave_sum(s2);
        if (c.lane < 12) ssq_q[(size_t)row * 12 + c.lane] = c.lane == 0 ? s : 0.f;
        if (c.lane < 8) ssq_kv[(size_t)row * 8 + c.lane] = c.lane == 0 ? s2 : 0.f;
    }
}
__device__ __forceinline__ void nrope_apply(bf16_t* Q, const bf16_t* kper, bf16_t* kpe, const float* cosT, const float* sinT, const Ctx& c) {
    for (int i = c.gt; i < T * 5 * 32; i += c.ngt) {
        const int k = i & 31, hh = (i >> 5) % 5, row = i / 160;
        const float cs = cosT[row * 32 + k], sn = sinT[row * 32 + k];
        if (hh < 4) { bf16_t* q = Q + (size_t)row * 768 + hh * DQK + DN; const float x1 = bf2f(q[k]), x2 = bf2f(q[k + 32]);
            q[k] = (bf16_t)f2bf(x1 * cs - x2 * sn); q[k + 32] = (bf16_t)f2bf(x2 * cs + x1 * sn); }
        else { const bf16_t* s = kper + (size_t)row * 64; const float x1 = bf2f(s[k]), x2 = bf2f(s[k + 32]);
            bf16_t* o = kpe + (size_t)row * 64; o[k] = (bf16_t)f2bf(x1 * cs - x2 * sn); o[k + 32] = (bf16_t)f2bf(x2 * cs + x1 * sn); }
    }
}

struct AttnDesc { const bf16_t* Q; int ldq, qhs; const bf16_t* K; int ldk, khs; const bf16_t* Kpe; const bf16_t* V; int ldv, vhs; bf16_t* O; int ldo, ohs; int SQ, SK; float scale; };
template <bool CAUSAL, bool PE>
__device__ __forceinline__ void nattn(const AttnDesc& d, const Ctx& c, float* wl  ) {
    constexpr int DQ = PE ? DQK : DN;
    const int nitems = BATCH * NH * d.SQ;
    float* qs = wl; float* pw = wl + 192;
    for (int it = c.gw; it < nitems; it += c.ngw) {
        const int i = it % d.SQ, bh = it / d.SQ, h = bh % NH, b = bh / NH;
        const bf16_t* qrow = d.Q + (size_t)(b * d.SQ + i) * d.ldq + h * d.qhs;
        asm volatile("s_waitcnt lgkmcnt(0)" ::: "memory");
        for (int dd = c.lane; dd < DQ; dd += 64) qs[dd] = bf2f(qrow[dd]) * d.scale;
        asm volatile("s_waitcnt lgkmcnt(0)" ::: "memory");
        const int nk = CAUSAL ? i + 1 : d.SK;
        float m = -1e30f, l = 0.f, o0 = 0.f, o1 = 0.f;
        for (int t0 = 0; t0 < nk; t0 += 64) {
            const int j = t0 + c.lane; const bool valid = j < nk; const int jj = valid ? j : nk - 1;
            const bf16_t* kr = d.K + (size_t)(b * d.SK + jj) * d.ldk + h * d.khs;
            float s = 0.f;
#pragma unroll 4
            for (int cc = 0; cc < 16; ++cc) { const bf16x8 kv = *(const bf16x8*)(kr + cc * 8); const f32x4 q0 = *(const f32x4*)(qs + cc * 8), q1 = *(const f32x4*)(qs + cc * 8 + 4);
                s += bfs(kv[0]) * q0.x + bfs(kv[1]) * q0.y + bfs(kv[2]) * q0.z + bfs(kv[3]) * q0.w + bfs(kv[4]) * q1.x + bfs(kv[5]) * q1.y + bfs(kv[6]) * q1.z + bfs(kv[7]) * q1.w; }
            if (PE) { const bf16_t* kp = d.Kpe + (size_t)(b * d.SK + jj) * DR;
#pragma unroll 4
                for (int cc = 0; cc < 8; ++cc) { const bf16x8 kv = *(const bf16x8*)(kp + cc * 8); const f32x4 q0 = *(const f32x4*)(qs + DN + cc * 8), q1 = *(const f32x4*)(qs + DN + cc * 8 + 4);
                    s += bfs(kv[0]) * q0.x + bfs(kv[1]) * q0.y + bfs(kv[2]) * q0.z + bfs(kv[3]) * q0.w + bfs(kv[4]) * q1.x + bfs(kv[5]) * q1.y + bfs(kv[6]) * q1.z + bfs(kv[7]) * q1.w; } }
            if (!valid) s = -__builtin_inff();
            const float mn = fmaxf(m, wave_max(s));
            const float alpha = __expf(m - mn);
            const float pj = valid ? __expf(s - mn) : 0.f;
            l = l * alpha + wave_sum(pj); o0 *= alpha; o1 *= alpha; m = mn;
            asm volatile("s_waitcnt lgkmcnt(0)" ::: "memory");
            pw[c.lane] = pj;
            asm volatile("s_waitcnt lgkmcnt(0)" ::: "memory");
            const int cnt = (nk - t0) < 64 ? (nk - t0) : 64;
            const bf16_t* vr = d.V + (size_t)(b * d.SK + t0) * d.ldv + h * d.vhs + c.lane;
            for (int e = 0; e < cnt; ++e) { const float pe = pw[e]; o0 += pe * bf2f(vr[(size_t)e * d.ldv]); o1 += pe * bf2f(vr[(size_t)e * d.ldv + 64]); }
        }
        const float il = 1.0f / l;
        bf16_t* orow = d.O + (size_t)(b * d.SQ + i) * d.ldo + h * d.ohs;
        orow[c.lane] = (bf16_t)f2bf(o0 * il); orow[c.lane + 64] = (bf16_t)f2bf(o1 * il);
    }
}

__device__ __forceinline__ void nlru(const bf16_t* U, const bf16_t* G, const float* conv_w, const float* conv_b, const float* w_a, const float* b_a,
                                     const float* w_x, const float* b_x, const float* lam, bf16_t* ycat, int item, int lane) {
    const int b = item / NBLK, n = item % NBLK, ch = n * BD + lane;
    float wa[64], wx[64];
#pragma unroll
    for (int dd = 0; dd < 64; ++dd) { wa[dd] = w_a[(size_t)(n * 64 + dd) * 64 + lane]; wx[dd] = w_x[(size_t)(n * 64 + dd) * 64 + lane]; }
    const float cw0 = conv_w[ch], cw1 = conv_w[LRUW + ch], cw2 = conv_w[2 * LRUW + ch], cw3 = conv_w[3 * LRUW + ch], cb = conv_b[ch];
    const float ba = b_a[n * 64 + lane], bx = b_x[n * 64 + lane];
    const float sp = log1pf(expf(-lam[ch]));
    float u3 = 0.f, u2 = 0.f, u1 = 0.f, hst = 0.f;
    for (int t = 0; t < SEQ; ++t) {
        const size_t row = (size_t)b * SEQ + t;
        const float u0 = bf2f(U[row * LRUW + ch]);
        const float xc = cb + cw0 * u3 + cw1 * u2 + cw2 * u1 + cw3 * u0;
        float ra = ba, ri = bx;
#pragma unroll
        for (int dd = 0; dd < 64; ++dd) { const float xd = __shfl(xc, dd); ra += xd * wa[dd]; ri += xd * wx[dd]; }
        const float rg = sigmoidf_(ra), ig = sigmoidf_(ri);
        const float log_a = -8.0f * rg * sp;
        const float a = expf(log_a);
        const float bb = sqrtf(-expm1f(2.0f * log_a)) * (ig * xc);
        hst = a * hst + bb;
        const float gt = bf2f(G[row * LRUW + ch]);
        ycat[row * DM + LRUW + ch] = (bf16_t)f2bf(hst * gelu_tanh(gt));
        u3 = u2; u2 = u1; u1 = u0;
    }
}


#define LAS __attribute__((address_space(3)))
constexpr size_t WB_GU1 = 16 * MiB, WB_GU2 = 27 * MiB, WB_DN1 = 38 * MiB, WB_DN2 = WB_DN1 + 5767168, WB_IN = 49 * MiB, WB_UQ = WB_IN + 3670016,
                 WB_UKV = WB_UQ + 786432, WB_OUT = 54 * MiB, WB_XQ = 56 * MiB, WB_XKV = 57 * MiB, WB_XO = 59 * MiB;
constexpr int NIN = 1792;

template <class DST>
__device__ __forceinline__ void transpose_items(const float* W, int K, int N, const float* gk, bf16_t* WT, DST dst, LAS float* scr, int worker, int nworkers, int lane) {
    const int nblk = N / 32, nitems = (K / 64) * nblk;
    for (int item = worker; item < nitems; item += nworkers) {
        const int kb = item / nblk, nb = item % nblk, k0 = 64 * kb, n0 = 32 * nb;
#pragma unroll 8
        for (int i = 0; i < 32; ++i) { const int kk = 2 * i + (lane >> 5); float w = W[(size_t)(k0 + kk) * N + n0 + (lane & 31)]; if (gk) w *= gk[k0 + kk]; scr[kk * 33 + (lane & 31)] = w; }
        asm volatile("s_waitcnt lgkmcnt(0)" ::: "memory");
        const int cc = lane & 7;
#pragma unroll
        for (int j = 0; j < 4; ++j) { const int n = (lane >> 3) + 8 * j; const LAS float* s = scr + (8 * cc) * 33 + n;
            u32x4 o; o.x = pk2(s[0 * 33], s[1 * 33]); o.y = pk2(s[2 * 33], s[3 * 33]); o.z = pk2(s[4 * 33], s[5 * 33]); o.w = pk2(s[6 * 33], s[7 * 33]);
            *(u32x4*)(WT + (size_t)dst(n0 + n) * K + k0 + 8 * cc) = o; }
        asm volatile("s_waitcnt lgkmcnt(0)" ::: "memory");
    }
}
__device__ __forceinline__ void nrope_kpe(const bf16_t* kper, bf16_t* kpe, const float* cosT, const float* sinT, const Ctx& c) {
    for (int i = c.gt; i < T * 32; i += c.ngt) {
        const int k = i & 31, row = i >> 5;
        const float cs = cosT[i], sn = sinT[i];
        const bf16_t* s = kper + (size_t)row * 64; const float x1 = bf2f(s[k]), x2 = bf2f(s[k + 32]);
        bf16_t* o = kpe + (size_t)row * 64; o[k] = (bf16_t)f2bf(x1 * cs - x2 * sn); o[k + 32] = (bf16_t)f2bf(x2 * cs + x1 * sn);
    }
}

#define MKCTX() int tid_ = threadIdx.x; asm volatile("" : "+v"(tid_)); Ctx c; c.tid = tid_; c.lane = c.tid & 63; c.wave = __builtin_amdgcn_readfirstlane(c.tid >> 6); \
    c.gw = blockIdx.x * NWAVES + c.wave; c.ngw = gridDim.x * NWAVES; c.gt = blockIdx.x * NTHREADS + c.tid; c.ngt = gridDim.x * NTHREADS; float* wl = (float*)lds + c.wave * 256; (void)wl
enum Step { ST_PREP = 0, ST_GU1, ST_DN1, ST_RN1, ST_WIN, ST_QG, ST_KVG, ST_KPE, ST_MIX, ST_WOUT, ST_RN2, ST_XQ, ST_MEMKV, ST_XATT, ST_XO, ST_RN3, ST_GU2, ST_DN2, ST_RN4, ST_END };

template <int STEP>
__device__ __forceinline__ void do_step(const Params& p, unsigned char* lds) {
    constexpr int step = STEP;
    const int G = gridDim.x, bid = blockIdx.x;
    unsigned char* ws = p.ws;
    float* rs0 = (float*)(ws + WS_RS); float* rs1 = rs0 + T; float* rs2 = rs1 + T; float* rs3 = rs2 + T;
    float* ssq_q = (float*)(ws + WS_SSQQ); float* ssq_kv = (float*)(ws + WS_SSQKV);
    float* cosT = (float*)(ws + WS_COS); float* sinT = (float*)(ws + WS_SIN);
    bf16_t* memn = (bf16_t*)(ws + WS_MEMN); bf16_t* memkv = (bf16_t*)(ws + WS_MEMKV);
    bf16_t* xb = (bf16_t*)(ws + WS_XB); bf16_t* hid = (bf16_t*)(ws + WS_HID);
    bf16_t* cq = (bf16_t*)(ws + WS_CQ); bf16_t* ckv = (bf16_t*)(ws + WS_CKV); bf16_t* kper = (bf16_t*)(ws + WS_KPER); bf16_t* ub = (bf16_t*)(ws + WS_U); bf16_t* gateb = (bf16_t*)(ws + WS_GATE);
    bf16_t* Qb = (bf16_t*)(ws + WS_Q); bf16_t* kpe = (bf16_t*)(ws + WS_KPE); bf16_t* KVb = (bf16_t*)(ws + WS_KV);
    bf16_t* qx = (bf16_t*)(ws + WS_QX); bf16_t* ox = (bf16_t*)(ws + WS_OX); bf16_t* ycat = (bf16_t*)(ws + WS_YCAT);
    float* YA = (float*)(ws + WS_YA); float* YB = (float*)(ws + WS_YB);
    LAS unsigned char* ldsl = (LAS unsigned char*)lds;
        switch (step) {
        case ST_PREP: { MKCTX();
            nrow_prep(p.in[I_X], xb, rs0, T, c);
            nrow_memn(p.in[I_MEM], p.in[I_MEMG], memn, c);
            nrope_tables((const int*)p.in[I_POS], cosT, sinT, c);
            LAS float* scr = (LAS float*)(ldsl + c.wave * 16384);
            int off = 0;
#define TR(W, K, N, GK, DSTP, ...) do { transpose_items(W, K, N, GK, (bf16_t*)(ws + (DSTP)), __VA_ARGS__, scr, (c.gw + c.ngw - (off % c.ngw)) % c.ngw, c.ngw, c.lane); off += ((K) / 64) * ((N) / 32); } while (0)
            auto dgu = [](int n) { const int j = n < DFF ? n : n - DFF; return 256 * (j >> 7) + (n < DFF ? 0 : 128) + (j & 127); };
            auto did = [](int n) { return n; };
            auto din = [](int n) { return n < 704 ? n : n + 64; };
            auto duq = [](int n) { const int h = n / DQK, d = n % DQK; return d < DN ? h * DN + d : (d < DN + 32 ? 512 + 32 * h + (d - DN) : 640 + 32 * h + (d - DN - 32)); };
            TR(p.in[I_F1GU], DM, 2 * DFF, p.in[I_F1PRE], WB_GU1, dgu);
            TR(p.in[I_F2GU], DM, 2 * DFF, p.in[I_F2PRE], WB_GU2, dgu);
            TR(p.in[I_F1DN], DFF, DM, nullptr, WB_DN1, did);
            TR(p.in[I_F2DN], DFF, DM, nullptr, WB_DN2, did);
            TR(p.in[I_WIN], DM, INC, p.in[I_MIXPRE], WB_IN, din);
            TR(p.in[I_WUQ], QLR, NH * DQK, p.in[I_QAG], WB_UQ, duq);
            TR(p.in[I_WUKV], KVLR, NH * 256, p.in[I_KVAG], WB_UKV, did);
            TR(p.in[I_WOUT], DM, DM, nullptr, WB_OUT, did);
            TR(p.in[I_XAWQ], DM, XAW, p.in[I_XAPRE], WB_XQ, did);
            TR(p.in[I_XAWKV], DM, 2 * XAW, nullptr, WB_XKV, did);
            TR(p.in[I_XAWO], XAW, DM, nullptr, WB_XO, did);
#undef TR
            { u32x4* z = (u32x4*)(ws + WB_IN + (size_t)704 * DM * 2); for (int i = c.gt; i < 64 * DM * 2 / 16; i += c.ngt) z[i] = (u32x4){0u, 0u, 0u, 0u}; }
        } break;
        case ST_GU1: case ST_GU2: {
            const bool f1 = step == ST_GU1;
            pg8::Gemm g{xb, (const bf16_t*)(ws + (f1 ? WB_GU1 : WB_GU2)), T, 2 * DFF, DM}; pg8::StaticOrder S; S.init(T, 2 * DFF, G, bid);
            pg8::EpiSwiGLU E{hid, DFF, f1 ? rs0 : rs3};
            pg8::gemm_phase<pg8::EpiSwiGLU, pg8::StaticOrder, true, true>(ldsl, g, S, E);
        } break;
        case ST_DN1: case ST_WOUT: case ST_XO: case ST_DN2: {
            const bf16_t* A = (step == ST_WOUT) ? ycat : (step == ST_XO) ? ox : hid;
            const size_t wb = (step == ST_DN1) ? WB_DN1 : (step == ST_DN2) ? WB_DN2 : (step == ST_WOUT) ? WB_OUT : WB_XO;
            const int K = (step == ST_WOUT) ? DM : (step == ST_XO) ? XAW : DFF;
            float* Y = (step == ST_DN1 || step == ST_DN2) ? YA : YB;
            pg8::Gemm g{A, (const bf16_t*)(ws + wb), T, DM, K}; pg8::StaticOrder S; S.init(T, DM, G, bid);
            pg8::EpiF32 E{Y, DM};
            pg8::gemm_phase<pg8::EpiF32, pg8::StaticOrder, true, true>(ldsl, g, S, E);
        } break;
        case ST_RN1: case ST_RN2: case ST_RN3: case ST_RN4: { MKCTX();
            const float* base = (step == ST_RN1) ? p.in[I_X] : p.out;
            const float* y = (step == ST_RN1 || step == ST_RN4) ? YA : YB;
            const float* g = p.in[(step == ST_RN1) ? I_F1POST : (step == ST_RN2) ? I_MIXPOST : (step == ST_RN3) ? I_XAPOST : I_F2POST];
            const float coef = (step == ST_RN1 || step == ST_RN4) ? 0.5f : 1.0f;
            float* rso = (step == ST_RN1) ? rs1 : (step == ST_RN2) ? rs2 : (step == ST_RN3) ? rs3 : rs0;
            nrow_resnorm(base, y, g, coef, p.out, xb, rso, c);
        } break;
        case ST_WIN: {
            pg8::Gemm g{xb, (const bf16_t*)(ws + WB_IN), T, NIN, DM}; pg8::StaticOrder S; S.init(T, NIN, G, bid);
            pg8::EpiWin E{cq, ckv, kper, ub, gateb, rs1, ssq_q, ssq_kv};
            pg8::gemm_phase<pg8::EpiWin, pg8::StaticOrder, true, true>(ldsl, g, S, E);
        } break;
        case ST_QG: {
            pg8::Gemm g{cq, (const bf16_t*)(ws + WB_UQ), T, NH * DQK, QLR}; pg8::StaticOrder S; S.init(T, NH * DQK, G, bid);
            pg8::EpiQ E{Qb, ssq_q, cosT, sinT};
            pg8::gemm_phase<pg8::EpiQ, pg8::StaticOrder, true, true>(ldsl, g, S, E);

        } break;
        case ST_KVG: case ST_XQ: case ST_MEMKV: {
            const bf16_t* A = (step == ST_KVG) ? ckv : (step == ST_XQ) ? xb : memn;
            const size_t wb = (step == ST_KVG) ? WB_UKV : (step == ST_XQ) ? WB_XQ : WB_XKV;
            const int M = (step == ST_MEMKV) ? MT : T, N = (step == ST_XQ) ? XAW : 1024, K = (step == ST_KVG) ? KVLR : DM;
            bf16_t* O = (step == ST_KVG) ? KVb : (step == ST_XQ) ? qx : memkv;
            pg8::Gemm g{A, (const bf16_t*)(ws + wb), M, N, K}; pg8::StaticOrder S; S.init(M, N, G, bid);
            pg8::EpiRowScale E{O, N, (step == ST_KVG) ? 2 : (step == ST_XQ) ? 1 : 0, (step == ST_KVG) ? ssq_kv : rs2, 8, 1.0f / KVLR};
            pg8::gemm_phase<pg8::EpiRowScale, pg8::StaticOrder, true, true>(ldsl, g, S, E);

        } break;
        case ST_KPE: { MKCTX(); nrope_kpe(kper, kpe, cosT, sinT, c); } break;
        case ST_MIX: { MKCTX();
            if (c.wave == 0 && bid < 32)
                nlru(ub, gateb, p.in[I_CONVW], p.in[I_CONVB], p.in[I_RGWA], p.in[I_RGBA], p.in[I_RGWX], p.in[I_RGBX], p.in[I_LAM], ycat, bid, c.lane);
            AttnDesc d{Qb, 768, DQK, KVb, 1024, 256, kpe, KVb + DN, 1024, 256, ycat, DM, DV, SEQ, SEQ, 0.07216878364870322f};
            nattn<true, true>(d, c, wl);
        } break;
        case ST_XATT: { MKCTX();
            AttnDesc d{qx, XAW, 128, memkv, 1024, 128, nullptr, memkv + XAW, 1024, 128, ox, XAW, 128, SEQ, MEML, 0.08838834764831845f};
            nattn<false, false>(d, c, wl);
        } break;
        default: break;
        }
}
__device__ __forceinline__ constexpr bool step_sync(int s) { return !(s == ST_QG || s == ST_KVG || s == ST_XQ || s == ST_END - 1); }
template <int STEP> __device__ __forceinline__ void run_steps(const Params& p, unsigned char* lds, cg::grid_group& grid) {
    if constexpr (STEP < ST_END) {
        do_step<STEP>(p, lds);
        if constexpr (step_sync(STEP)) grid.sync();
        run_steps<STEP + 1>(p, lds, grid);
    }
}
__global__ void __launch_bounds__(NTHREADS, 2) fwd_kernel(Params p) {
    cg::grid_group grid = cg::this_grid();
    extern __shared__ __attribute__((aligned(16))) unsigned char lds[];
    run_steps<0>(p, lds, grid);
}

extern "C" void kernel_launch(void* const* d_in, const int* in_sizes, int n_in, void* d_out, int out_size, void* d_ws, size_t ws_size, hipStream_t stream) {
    static int grid_blocks = 0;
    if (grid_blocks == 0) {
        if (n_in != 32 || out_size != T * DM || ws_size < WS_END) { fprintf(stderr, "kernel_launch: unexpected shapes (n_in %d out %d ws %zu)\n", n_in, out_size, ws_size); grid_blocks = -1; return; }
        int dev = 0, cus = 0, per_cu = 0;
        (void)hipGetDevice(&dev);
        (void)hipDeviceGetAttribute(&cus, hipDeviceAttributeMultiprocessorCount, dev);
        (void)hipFuncSetAttribute((const void*)fwd_kernel, hipFuncAttributeMaxDynamicSharedMemorySize, LDS_BYTES);
        (void)hipOccupancyMaxActiveBlocksPerMultiprocessor(&per_cu, (const void*)fwd_kernel, NTHREADS, LDS_BYTES);
        if (per_cu < 1) { fprintf(stderr, "kernel_launch: occupancy query says %d blocks per CU\n", per_cu); per_cu = 1; }
        if (per_cu > 1) per_cu = 1;
        grid_blocks = cus * per_cu;
        (void)hipGetLastError();
    }
    if (grid_blocks < 0) return;
    (void)hipMemsetAsync((char*)d_ws + WS_CTL, 0, CTL_ZERO_BYTES, stream);
    Params p{};
    for (int i = 0; i < 32; ++i) p.in[i] = (const float*)d_in[i];
    p.out = (float*)d_out; p.ws = (unsigned char*)d_ws;
    void* args[] = {&p};
    hipError_t e = hipLaunchCooperativeKernel((const void*)fwd_kernel, dim3(grid_blocks), dim3(NTHREADS), args, LDS_BYTES, stream);
    if (e != hipSuccess) fprintf(stderr, "cooperative launch failed: %s (grid %d)\n", hipGetErrorString(e), grid_blocks);
}
```

```cpp
#include <hip/hip_runtime.h>
#include <hip/hip_cooperative_groups.h>
#include <cstdio>
#include <cstdint>
namespace cg = cooperative_groups;

typedef unsigned short bf16_t;
typedef short bf16x8 __attribute__((ext_vector_type(8)));
typedef float f32x4 __attribute__((ext_vector_type(4)));
typedef float f32x16 __attribute__((ext_vector_type(16)));
typedef unsigned u32x2 __attribute__((ext_vector_type(2)));
typedef unsigned u32x4 __attribute__((ext_vector_type(4)));

constexpr int BATCH = 4, SEQ = 8192, T = BATCH * SEQ, DM = 1024, MEML = 256, MT = BATCH * MEML;
constexpr int NH = 4, DN = 128, DR = 64, DQK = 192, DV = 128, QLR = 384, KVLR = 256;
constexpr int LRUW = 512, NBLK = 8, BD = 64, INC = 1728, DFF = 2816;
constexpr int XAW = 512;
constexpr float EPS = 1e-6f;
constexpr int NTHREADS = 512, NWAVES = 8;
constexpr int LDS_BYTES = 147456;

constexpr size_t MiB = 1u << 20;
constexpr size_t WS_CTL = 0, CTL_ZERO_BYTES = 1 * MiB;
constexpr size_t WS_RS = 1 * MiB;
constexpr size_t WS_SSQQ = 2 * MiB;
constexpr size_t WS_SSQKV = 4 * MiB;
constexpr size_t WS_LRUSUM = 5 * MiB;
constexpr size_t WS_COS = 8 * MiB, WS_SIN = 12 * MiB;
constexpr size_t WS_W = 16 * MiB;
constexpr size_t WS_MEMN = 60 * MiB, WS_MEMKV = 62 * MiB;
constexpr size_t WS_XB = 64 * MiB;
constexpr size_t WS_HID = 128 * MiB;
constexpr size_t WS_CQ = 128 * MiB, WS_CKV = 152 * MiB, WS_KPER = 168 * MiB, WS_U = 172 * MiB, WS_GATE = 204 * MiB, WS_Q = 236 * MiB, WS_KPE = 284 * MiB;
constexpr size_t WS_KV = 304 * MiB, WS_QX = 304 * MiB, WS_OX = 336 * MiB;
constexpr size_t WS_YCAT = 368 * MiB;
constexpr size_t WS_LRUH = 432 * MiB, WS_LRUP = 464 * MiB;
constexpr size_t WS_YA = 304 * MiB, WS_YB = 128 * MiB;
constexpr size_t WS_END = 512 * MiB;

struct Params { const float* in[32]; float* out; unsigned char* ws; };
enum { I_X = 0, I_MEM, I_POS, I_F1PRE, I_F1GU, I_F1DN, I_F1POST, I_MIXPRE, I_WIN, I_QAG, I_WUQ, I_KVAG, I_WUKV, I_CONVW, I_CONVB,
       I_RGWA, I_RGBA, I_RGWX, I_RGBX, I_LAM, I_WOUT, I_MIXPOST, I_XAPRE, I_MEMG, I_XAWQ, I_XAWKV, I_XAWO, I_XAPOST, I_F2PRE, I_F2GU, I_F2DN, I_F2POST };

struct Ctx { int tid, lane, wave, gw, ngw, gt, ngt; };

__device__ __forceinline__ float bf2f(bf16_t v) { return __uint_as_float((unsigned)v << 16); }
__device__ __forceinline__ float bfs(short v) { return __uint_as_float(((unsigned)(unsigned short)v) << 16); }
__device__ __forceinline__ unsigned f2bf(float f) { unsigned u = __float_as_uint(f); return (u + 0x7fffu + ((u >> 16) & 1u)) >> 16; }
__device__ __forceinline__ unsigned pk2(float lo, float hi) { return f2bf(lo) | (f2bf(hi) << 16); }
__device__ __forceinline__ float wave_sum(float v) {
#pragma unroll
    for (int o = 1; o < 64; o <<= 1) v += __shfl_xor(v, o);
    return v;
}
__device__ __forceinline__ float wave_max(float v) {
#pragma unroll
    for (int o = 1; o < 64; o <<= 1) v = fmaxf(v, __shfl_xor(v, o));
    return v;
}
__device__ __forceinline__ float sigmoidf_(float x) { return 1.0f / (1.0f + __expf(-x)); }
__device__ __forceinline__ float siluf_(float x) { return x / (1.0f + __expf(-x)); }
__device__ __forceinline__ float gelu_tanh(float x) { const float u = 0.7978845608028654f * (x + 0.044715f * x * x * x); return 0.5f * x * (1.0f + tanhf(u)); }
__device__ __forceinline__ int crow(int r, int hi) { return (r & 3) + 8 * (r >> 2) + 4 * hi; }

namespace pg8 {
#define PG8_LAS __attribute__((address_space(3)))
typedef unsigned short bf16_t;
typedef short bf16x8 __attribute__((ext_vector_type(8)));
typedef float f32x4 __attribute__((ext_vector_type(4)));
typedef unsigned u32x4 __attribute__((ext_vector_type(4)));
constexpr int BM = 256, BK = 64, HALF = 128, HTB = HALF * BK * 2  , STAGE_BYTES = 8 * HTB, NXCD = 8, WGM = 8;

__host__ __device__ __forceinline__ int lds_byte(int r, int c) { const int st = (r >> 4) * 2 + (c >> 5), rr = r & 15, cc = c & 31, ob = rr * 64 + cc * 2; return st * 1024 + (ob ^ (((ob >> 9) & 1) << 5)); }
__host__ __device__ __forceinline__ void stage_rc(int b, int& R, int& C) { const int st = b / 1024, sb = b % 1024, swz = sb ^ (((sb >> 9) & 1) << 5); R = (st >> 1) * 16 + swz / 64; C = (st & 1) * 32 + (swz % 64) / 2; }
__host__ __device__ __forceinline__ int perm32(int rho) { const int n = rho >> 4, i = rho & 15; return 8 * (i >> 2) + 4 * n + (i & 3); }

struct Unit { int pm, pn; };
struct Gemm { const bf16_t* A; const bf16_t* Bt; int M, N, K; };

struct StaticOrder {
    int nM, nN, nwg, G, c;
    __host__ __device__ void init(int M, int N, int G_, int c_) { nM = M / BM; nN = N / BM; nwg = nM * nN; G = G_; c = c_; }
    __host__ __device__ bool next(int i, Unit& u) const {
        const long L = (long)i * G + c; if (L >= nwg) return false;
        int wgid = (int)L; { const int q = nwg / NXCD, r = nwg % NXCD, xcd = wgid % NXCD, off = wgid / NXCD; wgid = (xcd < r ? xcd * (q + 1) : r * (q + 1) + (xcd - r) * q) + off; }
        const int nig = WGM * nN, gid = wgid / nig, fm = gid * WGM, gsz = (nM - fm) < WGM ? (nM - fm) : WGM;
        u.pm = fm + ((wgid % nig) % gsz); u.pn = (wgid % nig) / gsz; return true;
    }
    __device__ __forceinline__ void a_ready(const Unit&) const {}
    __device__ __forceinline__ void done(const Unit&) const {}
};

__device__ __forceinline__ unsigned cvt_pk_bf16(float lo, float hi) { unsigned r; asm volatile("v_cvt_pk_bf16_f32 %0, %1, %2" : "=v"(r) : "v"(lo), "v"(hi)); return r; }
typedef float f32x2 __attribute__((ext_vector_type(2)));

__device__ __forceinline__ u32x4 pack8s(f32x4 a, f32x4 b, float s) { u32x4 w; w.x = cvt_pk_bf16(a[0] * s, a[1] * s); w.y = cvt_pk_bf16(a[2] * s, a[3] * s); w.z = cvt_pk_bf16(b[0] * s, b[1] * s); w.w = cvt_pk_bf16(b[2] * s, b[3] * s); return w; }
__device__ __forceinline__ float silu_f(float x) { return x * __builtin_amdgcn_rcpf(1.0f + __expf(-x)); }

struct EpiF32 {
    static constexpr bool PERM = false, AFTER_DRAIN = false;
    float* C; int ldc;
    __device__ __forceinline__ void operator()(const f32x4 (&acc)[2][2][4][2], const Unit& u, int wr, int wc, int fr, int fq) const {
        const int row0 = u.pm * BM + wr * 64 + fr, col0 = u.pn * BM + wc * 32 + 4 * fq;
#pragma unroll
        for (int ai = 0; ai < 2; ++ai)
#pragma unroll
            for (int m = 0; m < 4; ++m) { float* rowp = C + (size_t)(row0 + ai * HALF + m * 16) * ldc + col0;
#pragma unroll
                for (int bj = 0; bj < 2; ++bj)
#pragma unroll
                    for (int n = 0; n < 2; ++n) *(f32x4*)(rowp + bj * HALF + n * 16) = acc[ai][bj][m][n]; }
    }
};
struct EpiSwiGLU {
    static constexpr bool PERM = true, AFTER_DRAIN = false;
    bf16_t* H; int ldh; const float* rs;
    __device__ __forceinline__ void operator()(const f32x4 (&acc)[2][2][4][2], const Unit& u, int wr, int wc, int fr, int fq) const {
        const int row0 = u.pm * BM + wr * 64 + fr, col0 = u.pn * HALF + wc * 32 + 8 * fq;
#pragma unroll
        for (int ai = 0; ai < 2; ++ai)
#pragma unroll
            for (int m = 0; m < 4; ++m) { const int row = row0 + ai * HALF + m * 16; const float s = rs[row];
                float h[8];
#pragma unroll
                for (int n = 0; n < 2; ++n)
#pragma unroll
                    for (int e = 0; e < 4; ++e) h[n * 4 + e] = silu_f(acc[ai][0][m][n][e] * s) * (acc[ai][1][m][n][e] * s);
                u32x4 w; w.x = cvt_pk_bf16(h[0], h[1]); w.y = cvt_pk_bf16(h[2], h[3]); w.z = cvt_pk_bf16(h[4], h[5]); w.w = cvt_pk_bf16(h[6], h[7]);
                *(u32x4*)(H + (size_t)row * ldh + col0) = w; }
    }
};
struct EpiRowScale {
    static constexpr bool PERM = true, AFTER_DRAIN = false;
    bf16_t* O; int ldc; int mode; const float* sc; int nslot; float inv_dim;
    __device__ __forceinline__ void operator()(const f32x4 (&acc)[2][2][4][2], const Unit& u, int wr, int wc, int fr, int fq) const {
        const int row0 = u.pm * BM + wr * 64 + fr, col0 = u.pn * BM + wc * 32 + 8 * fq;
#pragma unroll
        for (int ai = 0; ai < 2; ++ai)
#pragma unroll
            for (int m = 0; m < 4; ++m) { const int row = row0 + ai * HALF + m * 16; float s = 1.0f;
                if (mode == 1) s = sc[row];
                else if (mode == 2) { float t = 0.f; const f32x4* sp = (const f32x4*)(sc + (size_t)row * nslot);
                    for (int k = 0; k < nslot / 4; ++k) { const f32x4 q = sp[k]; t += (q[0] + q[1]) + (q[2] + q[3]); }
                    s = rsqrtf(t * inv_dim + EPS); }
                bf16_t* rowp = O + (size_t)row * ldc + col0;
#pragma unroll
                for (int bj = 0; bj < 2; ++bj) *(u32x4*)(rowp + bj * HALF) = pack8s(acc[ai][bj][m][0], acc[ai][bj][m][1], s); }
    }
};
struct EpiWin {
    static constexpr bool PERM = true, AFTER_DRAIN = false;
    bf16_t *cq, *ckv, *kper, *ub, *gate; const float* rs; float *ssq_q, *ssq_kv;
    __device__ __forceinline__ void operator()(const f32x4 (&acc)[2][2][4][2], const Unit& u, int wr, int wc, int fr, int fq) const {
        const int row0 = u.pm * BM + wr * 64 + fr, cl = wc * 32 + 8 * fq;
#pragma unroll
        for (int ai = 0; ai < 2; ++ai)
#pragma unroll
            for (int m = 0; m < 4; ++m) { const int row = row0 + ai * HALF + m * 16; const float s = rs[row];
#pragma unroll
                for (int bj = 0; bj < 2; ++bj) { const int hb = 2 * u.pn + bj;
                    const f32x4 v0 = acc[ai][bj][m][0] * s, v1 = acc[ai][bj][m][1] * s;
                    bf16_t* dst;
                    if (hb < 3) dst = cq + (size_t)row * 384 + hb * 128 + cl;
                    else if (hb < 5) dst = ckv + (size_t)row * 256 + (hb - 3) * 128 + cl;
                    else if (hb == 5) dst = (wc < 2) ? kper + (size_t)row * 64 + cl : nullptr;
                    else if (hb < 10) dst = ub + (size_t)row * 512 + (hb - 6) * 128 + cl;
                    else dst = gate + (size_t)row * 512 + (hb - 10) * 128 + cl;
                    if (dst) *(u32x4*)dst = pack8s(v0, v1, 1.0f);
                    if (hb < 5) { float q = (v0[0] * v0[0] + v0[1] * v0[1]) + (v0[2] * v0[2] + v0[3] * v0[3]) + (v1[0] * v1[0] + v1[1] * v1[1]) + (v1[2] * v1[2] + v1[3] * v1[3]);
                        q += __shfl_xor(q, 16); q += __shfl_xor(q, 32);
                        if (fq == 0) { if (hb < 3) ssq_q[(size_t)row * 12 + hb * 4 + wc] = q; else ssq_kv[(size_t)row * 8 + (hb - 3) * 4 + wc] = q; } } } }
    }
};
struct EpiQ {
    static constexpr bool PERM = true, AFTER_DRAIN = false;
    bf16_t* Q; const float* ssq; const float* cosT; const float* sinT;
    __device__ __forceinline__ void operator()(const f32x4 (&acc)[2][2][4][2], const Unit& u, int wr, int wc, int fr, int fq) const {
        const int row0 = u.pm * BM + wr * 64 + fr;
#pragma unroll
        for (int ai = 0; ai < 2; ++ai)
#pragma unroll
            for (int m = 0; m < 4; ++m) { const int row = row0 + ai * HALF + m * 16;
                const f32x4* sp = (const f32x4*)(ssq + (size_t)row * 12); const f32x4 q0 = sp[0], q1 = sp[1], q2 = sp[2];
                const float t = ((q0[0] + q0[1]) + (q0[2] + q0[3])) + ((q1[0] + q1[1]) + (q1[2] + q1[3])) + ((q2[0] + q2[1]) + (q2[2] + q2[3]));
                const float s = rsqrtf(t * (1.0f / 384.0f) + EPS);
                bf16_t* qrow = Q + (size_t)row * 768;
                if (u.pn < 2) {
#pragma unroll
                    for (int bj = 0; bj < 2; ++bj) *(u32x4*)(qrow + (2 * u.pn + bj) * 192 + wc * 32 + 8 * fq) = pack8s(acc[ai][bj][m][0], acc[ai][bj][m][1], s);
                } else {
                    const f32x4 c0 = *(const f32x4*)(cosT + (size_t)row * 32 + 8 * fq), c1 = *(const f32x4*)(cosT + (size_t)row * 32 + 8 * fq + 4);
                    const f32x4 s0 = *(const f32x4*)(sinT + (size_t)row * 32 + 8 * fq), s1 = *(const f32x4*)(sinT + (size_t)row * 32 + 8 * fq + 4);
                    const f32x4 xa0 = acc[ai][0][m][0] * s, xa1 = acc[ai][0][m][1] * s, xb0 = acc[ai][1][m][0] * s, xb1 = acc[ai][1][m][1] * s;
                    const f32x4 o10 = xa0 * c0 - xb0 * s0, o11 = xa1 * c1 - xb1 * s1, o20 = xb0 * c0 + xa0 * s0, o21 = xb1 * c1 + xa1 * s1;
                    *(u32x4*)(qrow + wc * 192 + 128 + 8 * fq) = pack8s(o10, o11, 1.0f);
                    *(u32x4*)(qrow + wc * 192 + 160 + 8 * fq) = pack8s(o20, o21, 1.0f);
                } }
    }
};
template <class Epi, class Sched, bool ALIGN_EPI = false, bool SP2 = false>
__device__ __forceinline__ void gemm_phase(PG8_LAS unsigned char* lds, const Gemm g, const Sched& S, const Epi& E) {
    int tid_raw = threadIdx.x; asm volatile("" : "+v"(tid_raw));
    const int tid = tid_raw, wid = __builtin_amdgcn_readfirstlane(tid >> 6), lane = tid & 63, wr = wid >> 2, wc = wid & 3, fr = lane & 15, fq = lane >> 4;
    int K = g.K; asm volatile("" : "+s"(K));
    const int nt = K / BK;
    unsigned voffA[2], voffB[2];
#pragma unroll
    for (int i = 0; i < 2; ++i) { int R, C; stage_rc(tid * 16 + i * 8192, R, C); const int Rb = Epi::PERM ? ((R & ~31) + perm32(R & 31)) : R;
        voffA[i] = (unsigned)(R * K + C) * 2u; voffB[i] = (unsigned)(Rb * K + C) * 2u; }
    const size_t kstep = (size_t)(BK * 2);
    const size_t hstep = (size_t)HALF * K * 2;
    const size_t tstep = 2 * hstep;
    const unsigned ldsw = (unsigned)wid * 1024u;
    const int aoff = lds_byte(wr * 64 + fr, fq * 8), boff = lds_byte(wc * 32 + fr, fq * 8);
#define PG8_SA(b, h) (((b) * 2 + (h)) * HTB)
#define PG8_SB(b, h) ((4 + (b) * 2 + (h)) * HTB)
#define PG8_STAGE(bufoff, gbase, voff) do { _Pragma("unroll") for (int _i = 0; _i < 2; ++_i) \
        __builtin_amdgcn_global_load_lds((const unsigned*)((const char*)(gbase) + (voff)[_i]), (PG8_LAS unsigned*)(lds + (bufoff) + ldsw + _i * 8192), 16, 0, 0); } while (0)
#define PG8_LDA(dst, b, h) do { _Pragma("unroll") for (int m = 0; m < 4; ++m) _Pragma("unroll") for (int k = 0; k < 2; ++k) dst[m][k] = *(const PG8_LAS bf16x8*)(lds + PG8_SA(b, h) + aoff + m * 2048 + k * 1024); } while (0)
#define PG8_LDB(dst, b, h) do { _Pragma("unroll") for (int n = 0; n < 2; ++n) _Pragma("unroll") for (int k = 0; k < 2; ++k) dst[n][k] = *(const PG8_LAS bf16x8*)(lds + PG8_SB(b, h) + boff + n * 2048 + k * 1024); } while (0)
#define PG8_MMA(ai, bj, At, Bt) do { __builtin_amdgcn_s_setprio(1); _Pragma("unroll") for (int m = 0; m < 4; ++m) _Pragma("unroll") for (int n = 0; n < 2; ++n) _Pragma("unroll") for (int k = 0; k < 2; ++k) \
        acc[ai][bj][m][n] = __builtin_amdgcn_mfma_f32_16x16x32_bf16(Bt[n][k], At[m][k], acc[ai][bj][m][n], 0, 0, 0); __builtin_amdgcn_s_setprio(0); } while (0)
#define PG8_WAIT_V(n) asm volatile("s_waitcnt vmcnt(" #n ")" ::: "memory")
#define PG8_WAIT_L(n) asm volatile("s_waitcnt lgkmcnt(" #n ")" ::: "memory")
#define PG8_BAR __builtin_amdgcn_s_barrier()
#define PG8_SCHED __builtin_amdgcn_sched_barrier(0)
    Unit cur, nxt; int ui = 0;
    if (!S.next(0, cur)) return;
    f32x4 acc[2][2][4][2];
#pragma unroll
    for (int a = 0; a < 2; ++a)
#pragma unroll
        for (int b = 0; b < 2; ++b)
#pragma unroll
            for (int m = 0; m < 4; ++m)
#pragma unroll
                for (int n = 0; n < 2; ++n) acc[a][b][m][n] = (f32x4){0.f, 0.f, 0.f, 0.f};
    bf16x8 At[4][2], B0[2][2], B1[2][2];
    const char* cA = (const char*)g.A + (size_t)cur.pm * tstep; const char* cB = (const char*)g.Bt + (size_t)cur.pn * tstep;
    S.a_ready(cur);
    if constexpr (SP2) {
        PG8_STAGE(PG8_SB(0, 0), cB, voffB); PG8_STAGE(PG8_SB(0, 1), cB + hstep, voffB); PG8_STAGE(PG8_SA(0, 0), cA, voffA); PG8_STAGE(PG8_SA(0, 1), cA + hstep, voffA);
        if (wr == 1) PG8_BAR;
        PG8_WAIT_V(2); PG8_BAR;
        PG8_STAGE(PG8_SB(1, 0), cB + kstep, voffB); PG8_STAGE(PG8_SA(1, 0), cA + kstep, voffA); PG8_STAGE(PG8_SB(1, 1), cB + hstep + kstep, voffB);
        PG8_WAIT_V(6); PG8_BAR;
    } else {
        PG8_STAGE(PG8_SB(0, 0), cB, voffB); PG8_STAGE(PG8_SA(0, 0), cA, voffA); PG8_STAGE(PG8_SB(0, 1), cB + hstep, voffB); PG8_STAGE(PG8_SA(0, 1), cA + hstep, voffA);
        if (wr == 1) PG8_BAR;
        PG8_WAIT_V(4); PG8_BAR;
        PG8_STAGE(PG8_SB(1, 0), cB + kstep, voffB); PG8_STAGE(PG8_SA(1, 0), cA + kstep, voffA); PG8_STAGE(PG8_SB(1, 1), cB + hstep + kstep, voffB);
        PG8_WAIT_V(6); PG8_BAR;
    }
    for (;;) {
        const bool has_next = S.next(ui + 1, nxt);
        const char* nA = has_next ? (const char*)g.A + (size_t)nxt.pm * tstep : cA; const char* nB = has_next ? (const char*)g.Bt + (size_t)nxt.pn * tstep : cB;
        for (int t = 0; t < nt; t += 2) {
            const bool last = (t == nt - 2);
            const char* a1 = cA + (size_t)(t + 1) * kstep;
            const char* a2 = last ? nA : cA + (size_t)(t + 2) * kstep; const char* b2 = last ? nB : cB + (size_t)(t + 2) * kstep;
            const char* a3 = a2 + kstep; const char* b3 = b2 + kstep;
            if (last && has_next) S.a_ready(nxt);
            if constexpr (SP2) {
            PG8_LDB(B0, 0, 0); PG8_LDB(B1, 0, 1); PG8_SCHED; PG8_LDA(At, 0, 0); PG8_STAGE(PG8_SA(1, 1), a1 + hstep, voffA);
            PG8_WAIT_V(8); PG8_WAIT_L(0); PG8_BAR; PG8_MMA(0, 0, At, B0); PG8_MMA(0, 1, At, B1); PG8_BAR; PG8_SCHED;
            PG8_LDA(At, 0, 1); PG8_STAGE(PG8_SB(0, 0), b2, voffB); PG8_STAGE(PG8_SB(0, 1), b2 + hstep, voffB); PG8_STAGE(PG8_SA(0, 0), a2, voffA);
            PG8_WAIT_V(8); PG8_WAIT_L(0); PG8_BAR; PG8_MMA(1, 0, At, B0); PG8_MMA(1, 1, At, B1); PG8_BAR; PG8_SCHED;
            PG8_LDB(B0, 1, 0); PG8_LDB(B1, 1, 1); PG8_SCHED; PG8_LDA(At, 1, 0); PG8_STAGE(PG8_SA(0, 1), a2 + hstep, voffA);
            PG8_WAIT_V(8); PG8_WAIT_L(0); PG8_BAR; PG8_MMA(0, 0, At, B0); PG8_MMA(0, 1, At, B1); PG8_BAR; PG8_SCHED;
            PG8_LDA(At, 1, 1); PG8_STAGE(PG8_SB(1, 0), b3, voffB); PG8_STAGE(PG8_SB(1, 1), b3 + hstep, voffB); PG8_STAGE(PG8_SA(1, 0), a3, voffA);
            PG8_WAIT_V(8); PG8_WAIT_L(0); PG8_BAR; PG8_MMA(1, 0, At, B0); PG8_MMA(1, 1, At, B1); PG8_BAR; PG8_SCHED;
            } else {
            PG8_LDB(B0, 0, 0); PG8_SCHED; PG8_LDA(At, 0, 0); PG8_STAGE(PG8_SA(1, 1), a1 + hstep, voffA);
            PG8_WAIT_L(8); PG8_BAR; PG8_WAIT_L(0); PG8_MMA(0, 0, At, B0); PG8_BAR; PG8_SCHED;
            PG8_LDB(B1, 0, 1); PG8_STAGE(PG8_SB(0, 0), b2, voffB);
            PG8_BAR; PG8_WAIT_L(0); PG8_MMA(0, 1, At, B1); PG8_BAR;
            PG8_LDA(At, 0, 1); PG8_STAGE(PG8_SA(0, 0), a2, voffA);
            PG8_BAR; PG8_WAIT_L(0); PG8_MMA(1, 0, At, B0); PG8_BAR; PG8_SCHED;
            PG8_STAGE(PG8_SB(0, 1), b2 + hstep, voffB);
            PG8_WAIT_V(6); PG8_BAR; PG8_MMA(1, 1, At, B1); PG8_BAR;
            PG8_LDB(B0, 1, 0); PG8_SCHED; PG8_LDA(At, 1, 0); PG8_STAGE(PG8_SA(0, 1), a2 + hstep, voffA);
            PG8_WAIT_L(8); PG8_BAR; PG8_WAIT_L(0); PG8_MMA(0, 0, At, B0); PG8_BAR; PG8_SCHED;
            PG8_LDB(B1, 1, 1); PG8_STAGE(PG8_SB(1, 0), b3, voffB);
            PG8_BAR; PG8_WAIT_L(0); PG8_MMA(0, 1, At, B1); PG8_BAR;
            PG8_LDA(At, 1, 1); PG8_STAGE(PG8_SA(1, 0), a3, voffA);
            PG8_BAR; PG8_WAIT_L(0); PG8_MMA(1, 0, At, B0); PG8_BAR; PG8_SCHED;
            PG8_STAGE(PG8_SB(1, 1), b3 + hstep, voffB);
            PG8_WAIT_V(6); PG8_BAR; PG8_MMA(1, 1, At, B1); PG8_BAR;
            }
        }
        if constexpr (ALIGN_EPI) { if (wr == 0) PG8_BAR; }
        if constexpr (!Epi::AFTER_DRAIN) { E(acc, cur, wr, wc, fr, fq); S.done(cur); }
        if (!has_next) break;
#pragma unroll
        for (int a = 0; a < 2; ++a)
#pragma unroll
            for (int b = 0; b < 2; ++b)
#pragma unroll
                for (int m = 0; m < 4; ++m)
#pragma unroll
                    for (int n = 0; n < 2; ++n) acc[a][b][m][n] = (f32x4){0.f, 0.f, 0.f, 0.f};
        cur = nxt; cA = nA; cB = nB; ++ui;
        if constexpr (ALIGN_EPI) { if (wr == 1) PG8_BAR; }
    }
    PG8_WAIT_V(0);
    if constexpr (!ALIGN_EPI) { if (wr == 0) PG8_BAR; }
    PG8_BAR;
    if constexpr (Epi::AFTER_DRAIN) { E.fused(acc, cur, wr, wc, fr, fq, lds, wid, lane); S.done(cur); }
#undef PG8_SA
#undef PG8_SB
#undef PG8_STAGE
#undef PG8_LDA
#undef PG8_LDB
#undef PG8_MMA
#undef PG8_WAIT_V
#undef PG8_WAIT_L
#undef PG8_BAR
#undef PG8_SCHED
}
}
template <bool PAIR, class RSF, class EPI>
__device__ __forceinline__ void ngemm(const bf16_t* A, int lda, const float* W, int ldw, const float* gk, int M, int N, int K, int pair_off,
                                      RSF rsf, EPI epi, const Ctx& c) {
    const int r = c.lane & 31, h = c.lane >> 5;
    const int ntn = N / 32, ntm = M / 64;
    for (int it = c.gw; it < ntm * ntn; it += c.ngw) {
        const int tn = it % ntn, tm = it / ntn;
        f32x16 a00 = {}, a10 = {}, a01 = {}, a11 = {};
        const bf16_t* a0 = A + (size_t)(tm * 64 + r) * lda + 8 * h;
        const bf16_t* a1 = a0 + (size_t)32 * lda;
        const float* w0 = W + (size_t)(8 * h) * ldw + tn * 32 + r;
        for (int k = 0; k < K; k += 16) {
            const bf16x8 fa0 = *(const bf16x8*)(a0 + k), fa1 = *(const bf16x8*)(a1 + k);
            bf16x8 fb, fb2;
#pragma unroll
            for (int j = 0; j < 8; ++j) {
                const float g = gk ? gk[k + 8 * h + j] : 1.0f;
                fb[j] = (short)f2bf(w0[(size_t)(k + j) * ldw] * g);
                if (PAIR) fb2[j] = (short)f2bf(w0[(size_t)(k + j) * ldw + pair_off] * g);
            }
            a00 = __builtin_amdgcn_mfma_f32_32x32x16_bf16(fa0, fb, a00, 0, 0, 0);
            a10 = __builtin_amdgcn_mfma_f32_32x32x16_bf16(fa1, fb, a10, 0, 0, 0);
            if (PAIR) {
                a01 = __builtin_amdgcn_mfma_f32_32x32x16_bf16(fa0, fb2, a01, 0, 0, 0);
                a11 = __builtin_amdgcn_mfma_f32_32x32x16_bf16(fa1, fb2, a11, 0, 0, 0);
            }
        }
        const int col = tn * 32 + r;
#pragma unroll
        for (int i = 0; i < 16; ++i) {
            const int row0 = tm * 64 + crow(i, h), row1 = row0 + 32;
            const float s0 = rsf(row0), s1 = rsf(row1);
            epi(row0, col, a00[i] * s0, a01[i] * s0);
            epi(row1, col, a10[i] * s1, a11[i] * s1);
        }
    }
}

__device__ __forceinline__ void nrow_prep(const float* x, bf16_t* xb, float* rs, int nrows, const Ctx& c) {
    for (int row = c.gw; row < nrows; row += c.ngw) {
        const f32x4* xr = (const f32x4*)(x + (size_t)row * DM) + c.lane;
        f32x4 v[4]; float ss = 0.f;
#pragma unroll
        for (int j = 0; j < 4; ++j) { v[j] = xr[64 * j]; ss += (v[j].x * v[j].x + v[j].y * v[j].y) + (v[j].z * v[j].z + v[j].w * v[j].w); }
        ss = wave_sum(ss);
        u32x2* o = (u32x2*)(xb + (size_t)row * DM) + c.lane;
#pragma unroll
        for (int j = 0; j < 4; ++j) { u32x2 w; w.x = pk2(v[j].x, v[j].y); w.y = pk2(v[j].z, v[j].w); o[64 * j] = w; }
        if (c.lane == 0) rs[row] = rsqrtf(ss * (1.0f / DM) + EPS);
    }
}
__device__ __forceinline__ void nrow_memn(const float* mem, const float* g, bf16_t* memn, const Ctx& c) {
    for (int row = c.gw; row < MT; row += c.ngw) {
        const f32x4* xr = (const f32x4*)(mem + (size_t)row * DM) + c.lane; const f32x4* gr = (const f32x4*)g + c.lane;
        f32x4 v[4]; float ss = 0.f;
#pragma unroll
        for (int j = 0; j < 4; ++j) { v[j] = xr[64 * j]; ss += (v[j].x * v[j].x + v[j].y * v[j].y) + (v[j].z * v[j].z + v[j].w * v[j].w); }
        const float rs = rsqrtf(wave_sum(ss) * (1.0f / DM) + EPS);
        u32x2* o = (u32x2*)(memn + (size_t)row * DM) + c.lane;
#pragma unroll
        for (int j = 0; j < 4; ++j) { const f32x4 gg = gr[64 * j]; u32x2 w; w.x = pk2(v[j].x * rs * gg.x, v[j].y * rs * gg.y); w.y = pk2(v[j].z * rs * gg.z, v[j].w * rs * gg.w); o[64 * j] = w; }
    }
}
__device__ __forceinline__ void nrope_tables(const int* pos, float* cosT, float* sinT, const Ctx& c) {
    for (int i = c.gt; i < T * 32; i += c.ngt) {
        const int row = i >> 5, k = i & 31;
        const float inv = (float)exp2(-(double)k * (13.287712379549449 / 32.0));
        const float ang = (float)pos[row] * inv;
        const double a = (double)ang; const double n = rint(a * 0.15915494309189535);
        const float rr = (float)((a - n * 6.283185307179586) - n * 2.4492935982947064e-16);
        cosT[i] = cosf(rr); sinT[i] = sinf(rr);
    }
}
__device__ __forceinline__ void nrow_resnorm(const float* base, const float* y, const float* g, float coef, float* xout, bf16_t* xb, float* rs_out, const Ctx& c) {
    for (int row = c.gw; row < T; row += c.ngw) {
        const f32x4* yr = (const f32x4*)(y + (size_t)row * DM) + c.lane; const f32x4* br = (const f32x4*)(base + (size_t)row * DM) + c.lane; const f32x4* gr = (const f32x4*)g + c.lane;
        f32x4 v[4]; float ss = 0.f;
#pragma unroll
        for (int j = 0; j < 4; ++j) { v[j] = yr[64 * j]; ss += (v[j].x * v[j].x + v[j].y * v[j].y) + (v[j].z * v[j].z + v[j].w * v[j].w); }
        const float rs = rsqrtf(wave_sum(ss) * (1.0f / DM) + EPS) * coef;
        float s2 = 0.f;
#pragma unroll
        for (int j = 0; j < 4; ++j) { const f32x4 gg = gr[64 * j], bb = br[64 * j]; v[j] = bb + v[j] * rs * gg; s2 += (v[j].x * v[j].x + v[j].y * v[j].y) + (v[j].z * v[j].z + v[j].w * v[j].w); }
        s2 = wave_sum(s2);
        f32x4* xo = (f32x4*)(xout + (size_t)row * DM) + c.lane; u32x2* o = (u32x2*)(xb + (size_t)row * DM) + c.lane;
#pragma unroll
        for (int j = 0; j < 4; ++j) { xo[64 * j] = v[j]; u32x2 w; w.x = pk2(v[j].x, v[j].y); w.y = pk2(v[j].z, v[j].w); o[64 * j] = w; }
        if (c.lane == 0) rs_out[row] = rsqrtf(s2 * (1.0f / DM) + EPS);
    }
}
__device__ __forceinline__ void nrow_ssq(const bf16_t* cq, const bf16_t* ckv, float* ssq_q, float* ssq_kv, const Ctx& c) {
    for (int row = c.gw; row < T; row += c.ngw) {
        float s = 0.f;
        for (int d = c.lane; d < QLR; d += 64) { const float v = bf2f(cq[(size_t)row * QLR + d]); s += v * v; }
        s = wave_sum(s);
        float s2 = 0.f;
        for (int d = c.lane; d < KVLR; d += 64) { const float v = bf2f(ckv[(size_t)row * KVLR + d]); s2 += v * v; }
        s2 = wave_sum(s2);
        if (c.lane < 12) ssq_q[(size_t)row * 12 + c.lane] = c.lane == 0 ? s : 0.f;
        if (c.lane < 8) ssq_kv[(size_t)row * 8 + c.lane] = c.lane == 0 ? s2 : 0.f;
    }
}
__device__ __forceinline__ void nrope_apply(bf16_t* Q, const bf16_t* kper, bf16_t* kpe, const float* cosT, const float* sinT, const Ctx& c) {
    for (int i = c.gt; i < T * 5 * 32; i += c.ngt) {
        const int k = i & 31, hh = (i >> 5) % 5, row = i / 160;
        const float cs = cosT[row * 32 + k], sn = sinT[row * 32 + k];
        if (hh < 4) { bf16_t* q = Q + (size_t)row * 768 + hh * DQK + DN; const float x1 = bf2f(q[k]), x2 = bf2f(q[k + 32]);
            q[k] = (bf16_t)f2bf(x1 * cs - x2 * sn); q[k + 32] = (bf16_t)f2bf(x2 * cs + x1 * sn); }
        else { const bf16_t* s = kper + (size_t)row * 64; const float x1 = bf2f(s[k]), x2 = bf2f(s[k + 32]);
            bf16_t* o = kpe + (size_t)row * 64; o[k] = (bf16_t)f2bf(x1 * cs - x2 * sn); o[k + 32] = (bf16_t)f2bf(x2 * cs + x1 * sn); }
    }
}

struct AttnDesc { const bf16_t* Q; int ldq, qhs; const bf16_t* K; int ldk, khs; const bf16_t* Kpe; const bf16_t* V; int ldv, vhs; bf16_t* O; int ldo, ohs; int SQ, SK; float scale; };
template <bool CAUSAL, bool PE>
__device__ __forceinline__ void nattn(const AttnDesc& d, const Ctx& c, float* wl  ) {
    constexpr int DQ = PE ? DQK : DN;
    const int nitems = BATCH * NH * d.SQ;
    float* qs = wl; float* pw = wl + 192;
    for (int it = c.gw; it < nitems; it += c.ngw) {
        const int i = it % d.SQ, bh = it / d.SQ, h = bh % NH, b = bh / NH;
        const bf16_t* qrow = d.Q + (size_t)(b * d.SQ + i) * d.ldq + h * d.qhs;
        asm volatile("s_waitcnt lgkmcnt(0)" ::: "memory");
        for (int dd = c.lane; dd < DQ; dd += 64) qs[dd] = bf2f(qrow[dd]) * d.scale;
        asm volatile("s_waitcnt lgkmcnt(0)" ::: "memory");
        const int nk = CAUSAL ? i + 1 : d.SK;
        float m = -1e30f, l = 0.f, o0 = 0.f, o1 = 0.f;
        for (int t0 = 0; t0 < nk; t0 += 64) {
            const int j = t0 + c.lane; const bool valid = j < nk; const int jj = valid ? j : nk - 1;
            const bf16_t* kr = d.K + (size_t)(b * d.SK + jj) * d.ldk + h * d.khs;
            float s = 0.f;
#pragma unroll 4
            for (int cc = 0; cc < 16; ++cc) { const bf16x8 kv = *(const bf16x8*)(kr + cc * 8); const f32x4 q0 = *(const f32x4*)(qs + cc * 8), q1 = *(const f32x4*)(qs + cc * 8 + 4);
                s += bfs(kv[0]) * q0.x + bfs(kv[1]) * q0.y + bfs(kv[2]) * q0.z + bfs(kv[3]) * q0.w + bfs(kv[4]) * q1.x + bfs(kv[5]) * q1.y + bfs(kv[6]) * q1.z + bfs(kv[7]) * q1.w; }
            if (PE) { const bf16_t* kp = d.Kpe + (size_t)(b * d.SK + jj) * DR;
#pragma unroll 4
                for (int cc = 0; cc < 8; ++cc) { const bf16x8 kv = *(const bf16x8*)(kp + cc * 8); const f32x4 q0 = *(const f32x4*)(qs + DN + cc * 8), q1 = *(const f32x4*)(qs + DN + cc * 8 + 4);
                    s += bfs(kv[0]) * q0.x + bfs(kv[1]) * q0.y + bfs(kv[2]) * q0.z + bfs(kv[3]) * q0.w + bfs(kv[4]) * q1.x + bfs(kv[5]) * q1.y + bfs(kv[6]) * q1.z + bfs(kv[7]) * q1.w; } }
            if (!valid) s = -__builtin_inff();
            const float mn = fmaxf(m, wave_max(s));
            const float alpha = __expf(m - mn);
            const float pj = valid ? __expf(s - mn) : 0.f;
            l = l * alpha + wave_sum(pj); o0 *= alpha; o1 *= alpha; m = mn;
            asm volatile("s_waitcnt lgkmcnt(0)" ::: "memory");
            pw[c.lane] = pj;
            asm volatile("s_waitcnt lgkmcnt(0)" ::: "memory");
            const int cnt = (nk - t0) < 64 ? (nk - t0) : 64;
            const bf16_t* vr = d.V + (size_t)(b * d.SK + t0) * d.ldv + h * d.vhs + c.lane;
            for (int e = 0; e < cnt; ++e) { const float pe = pw[e]; o0 += pe * bf2f(vr[(size_t)e * d.ldv]); o1 += pe * bf2f(vr[(size_t)e * d.ldv + 64]); }
        }
        const float il = 1.0f / l;
        bf16_t* orow = d.O + (size_t)(b * d.SQ + i) * d.ldo + h * d.ohs;
        orow[c.lane] = (bf16_t)f2bf(o0 * il); orow[c.lane + 64] = (bf16_t)f2bf(o1 * il);
    }
}

__device__ __forceinline__ void nlru(const bf16_t* U, const bf16_t* G, const float* conv_w, const float* conv_b, const float* w_a, const float* b_a,
                                     const float* w_x, const float* b_x, const float* lam, bf16_t* ycat, int item, int lane) {
    const int b = item / NBLK, n = item % NBLK, ch = n * BD + lane;
    float wa[64], wx[64];
#pragma unroll
    for (int dd = 0; dd < 64; ++dd) { wa[dd] = w_a[(size_t)(n * 64 + dd) * 64 + lane]; wx[dd] = w_x[(size_t)(n * 64 + dd) * 64 + lane]; }
    const float cw0 = conv_w[ch], cw1 = conv_w[LRUW + ch], cw2 = conv_w[2 * LRUW + ch], cw3 = conv_w[3 * LRUW + ch], cb = conv_b[ch];
    const float ba = b_a[n * 64 + lane], bx = b_x[n * 64 + lane];
    const float sp = log1pf(expf(-lam[ch]));
    float u3 = 0.f, u2 = 0.f, u1 = 0.f, hst = 0.f;
    for (int t = 0; t < SEQ; ++t) {
        const size_t row = (size_t)b * SEQ + t;
        const float u0 = bf2f(U[row * LRUW + ch]);
        const float xc = cb + cw0 * u3 + cw1 * u2 + cw2 * u1 + cw3 * u0;
        float ra = ba, ri = bx;
#pragma unroll
        for (int dd = 0; dd < 64; ++dd) { const float xd = __shfl(xc, dd); ra += xd * wa[dd]; ri += xd * wx[dd]; }
        const float rg = sigmoidf_(ra), ig = sigmoidf_(ri);
        const float log_a = -8.0f * rg * sp;
        const float a = expf(log_a);
        const float bb = sqrtf(-expm1f(2.0f * log_a)) * (ig * xc);
        hst = a * hst + bb;
        const float gt = bf2f(G[row * LRUW + ch]);
        ycat[row * DM + LRUW + ch] = (bf16_t)f2bf(hst * gelu_tanh(gt));
        u3 = u2; u2 = u1; u1 = u0;
    }
}


namespace att {
typedef short s16x4 __attribute__((ext_vector_type(4)));
constexpr int NW = 8, QBLK = 32, KVBLK = 64, QB = NW * QBLK, D = 128;
constexpr int SHM_V = KVBLK * D * 2, SHM_KN = KVBLK * D * 2, SHM_KP = KVBLK * 64 * 2, SHM_K = SHM_KN + SHM_KP;
constexpr float THR = 8.f;
#define KSWZ(row, colB) ((row) * 256 + ((colB) ^ (((row) & 7) << 4)))
#define SBAR() __builtin_amdgcn_sched_barrier(0)
__device__ __forceinline__ int v_st(int k, int c) { const int kk = (k & ~0xC) | ((k & 4) << 1) | ((k & 8) >> 1); return ((kk >> 3) * 4 + (c >> 5)) * 512 + ((kk & 7) * 32 + (c & 31)) * 2; }
__device__ __forceinline__ int v_rd_base(int lane) { return ((lane & 3) << 3) | (((lane >> 2) & 3) << 6) | (((lane >> 4) & 1) << 5) | (((lane >> 5) & 1) << 8); }
constexpr int v_rd_off(int d0, int ks, int half) { return d0 * 512 + ks * 4096 + half * 2048; }
__device__ __forceinline__ unsigned cvtpk(float lo, float hi) { unsigned r; asm volatile("v_cvt_pk_bf16_f32 %0, %1, %2" : "=v"(r) : "v"(lo), "v"(hi)); return r; }
__device__ __forceinline__ bf16x8 load8(const bf16_t* p) { return *reinterpret_cast<const bf16x8*>(p); }
__device__ __forceinline__ void mask_tile(f32x16& p0, f32x16& p1, int dq, unsigned W) {
    const float NEG = -__builtin_inff();
#pragma unroll
    for (int r = 0; r < 16; ++r) {
        const int c = (r & 3) + 8 * (r >> 2);
        if ((unsigned)(dq - c) >= W) p0[r] = NEG;
        if ((unsigned)(dq - c - 32) >= W) p1[r] = NEG;
    }
}
template <bool PE> __device__ __forceinline__ void partialSM(f32x16& p0, f32x16& p1, float& m_reg, float& mn, float& alpha) {
    constexpr float SCALE = PE ? 0.07216878364870322f : 0.08838834764831845f;
    float pmax = p0[0]; for (int r = 1; r < 16; ++r) pmax = fmaxf(pmax, p0[r]); for (int r = 0; r < 16; ++r) pmax = fmaxf(pmax, p1[r]);
    { auto rr = __builtin_amdgcn_permlane32_swap(__float_as_uint(pmax), __float_as_uint(pmax), false, false);
      pmax = fmaxf(__uint_as_float(rr[0]), __uint_as_float(rr[1])); }
    constexpr float C2 = 1.4426950408889634f * SCALE;
    if (__builtin_expect(__all((pmax - m_reg) * SCALE <= THR), 1)) { mn = m_reg; alpha = 1.f; }
    else { mn = fmaxf(m_reg, pmax); alpha = __builtin_amdgcn_exp2f((m_reg - mn) * C2); m_reg = mn; }
    const float mnL = -mn * C2;
    for (int r = 0; r < 16; ++r) p0[r] = fmaf(p0[r], C2, mnL); for (int r = 0; r < 16; ++r) p1[r] = fmaf(p1[r], C2, mnL);
    for (int r = 0; r < 16; ++r) p0[r] = __builtin_amdgcn_exp2f(p0[r]);
}
__device__ __forceinline__ void finishSM(f32x16& p0, f32x16& p1, float alpha, float& l_reg, bf16x8& pa0, bf16x8& pa1, bf16x8& pa2, bf16x8& pa3) {
    for (int r = 0; r < 16; ++r) p1[r] = __builtin_amdgcn_exp2f(p1[r]);
    float ps = 0; for (int r = 0; r < 16; ++r) ps += p0[r]; for (int r = 0; r < 16; ++r) ps += p1[r];
    { auto rr = __builtin_amdgcn_permlane32_swap(__float_as_uint(ps), __float_as_uint(ps), false, false);
      ps = __uint_as_float(rr[0]) + __uint_as_float(rr[1]); }
    l_reg = l_reg * alpha + ps;
#define PK4(P, B_, OUT) do { unsigned a0 = cvtpk(P[B_+0], P[B_+1]), a1 = cvtpk(P[B_+2], P[B_+3]);                          \
        unsigned b0 = cvtpk(P[B_+4], P[B_+5]), b1 = cvtpk(P[B_+6], P[B_+7]);                                             \
        auto r0 = __builtin_amdgcn_permlane32_swap(a0, b0, false, false); auto r1 = __builtin_amdgcn_permlane32_swap(a1, b1, false, false); \
        u32x4 w = {r0[0], r1[0], r0[1], r1[1]}; OUT = *reinterpret_cast<bf16x8*>(&w); } while (0)
    PK4(p0, 0, pa0); PK4(p0, 8, pa1); PK4(p1, 0, pa2); PK4(p1, 8, pa3);
#undef PK4
}
template <int KB, bool PE>
__device__ __forceinline__ void qkt(f32x16& p0, f32x16& p1, const char* K_lds, int r32, int hi, const bf16x8* qr, const char* qpe_l) {
    p0 = f32x16{}; p1 = f32x16{};
    const char* kb[4];
#pragma unroll
    for (int dd = 0; dd < 4; ++dd) kb[dd] = K_lds + KB * SHM_K + KSWZ(r32, (dd * 16 + hi * 8) * 2);
#pragma unroll
    for (int d0 = 0; d0 < 8; ++d0) { const char* a = kb[d0 & 3] + (d0 >> 2) * 128;
        bf16x8 b0 = *reinterpret_cast<const bf16x8*>(a);
        bf16x8 b1 = *reinterpret_cast<const bf16x8*>(a + 32 * 256);
        p0 = __builtin_amdgcn_mfma_f32_32x32x16_bf16(b0, qr[d0], p0, 0, 0, 0);
        p1 = __builtin_amdgcn_mfma_f32_32x32x16_bf16(b1, qr[d0], p1, 0, 0, 0); }
    if (PE) {
#pragma unroll
        for (int d0 = 0; d0 < 4; ++d0) { const char* a = kb[d0] + SHM_KN;
            bf16x8 b0 = *reinterpret_cast<const bf16x8*>(a);
            bf16x8 b1 = *reinterpret_cast<const bf16x8*>(a + 128);
            const bf16x8 qf = *reinterpret_cast<const bf16x8*>(qpe_l + d0 * 32);
            p0 = __builtin_amdgcn_mfma_f32_32x32x16_bf16(b0, qf, p0, 0, 0, 0);
            p1 = __builtin_amdgcn_mfma_f32_32x32x16_bf16(b1, qf, p1, 0, 0, 0); }
    }
}
__device__ __forceinline__ void pv_tile(f32x16* o, int vb0, bf16x8 pa0, bf16x8 pa1, bf16x8 pa2, bf16x8 pa3) {
#define TRRD(dst, off) asm volatile("ds_read_b64_tr_b16 %0, %1 offset:%2" : "=&v"(dst) : "v"(vb0), "i"(off) : "memory")
#define PV_D0(d0) do { s16x4 l0, l1, l2, l3, h0, h1, h2, h3; constexpr int b_ = v_rd_off(d0, 0, 0);   \
        TRRD(l0, b_); TRRD(h0, b_ + 2048); TRRD(l1, b_ + 4096); TRRD(h1, b_ + 6144); TRRD(l2, b_ + 8192); TRRD(h2, b_ + 10240); TRRD(l3, b_ + 12288); TRRD(h3, b_ + 14336); \
        asm volatile("s_waitcnt lgkmcnt(0)" ::: "memory"); SBAR();   \
        o[d0] = __builtin_amdgcn_mfma_f32_32x32x16_bf16(pa0, (bf16x8){l0[0], l0[1], l0[2], l0[3], h0[0], h0[1], h0[2], h0[3]}, o[d0], 0, 0, 0);   \
        o[d0] = __builtin_amdgcn_mfma_f32_32x32x16_bf16(pa1, (bf16x8){l1[0], l1[1], l1[2], l1[3], h1[0], h1[1], h1[2], h1[3]}, o[d0], 0, 0, 0);   \
        o[d0] = __builtin_amdgcn_mfma_f32_32x32x16_bf16(pa2, (bf16x8){l2[0], l2[1], l2[2], l2[3], h2[0], h2[1], h2[2], h2[3]}, o[d0], 0, 0, 0);   \
        o[d0] = __builtin_amdgcn_mfma_f32_32x32x16_bf16(pa3, (bf16x8){l3[0], l3[1], l3[2], l3[3], h3[0], h3[1], h3[2], h3[3]}, o[d0], 0, 0, 0); } while (0)
    PV_D0(0); PV_D0(1); PV_D0(2); PV_D0(3);
#undef PV_D0
#undef TRRD
}

struct BlockRef { const bf16_t* Q; const bf16_t* K; const bf16_t* Kp; const bf16_t* V; bf16_t* O; int P0; };
template <bool PE> struct Seam { bf16x8 qr[8]; bf16x8 qpe[4]; };
__device__ __forceinline__ int swa_jlo(int P0, int W) { const int lowk = P0 - W + 1; return lowk > 0 ? lowk / KVBLK : 0; }
constexpr int LDS_V = 0, LDS_K = 3 * SHM_V, LDS_QPE = LDS_K + 2 * SHM_K, QPE_WAVE = 32 * 144, LDS_WS = LDS_QPE + NW * QPE_WAVE, ATT_LDS_TOTAL = LDS_WS + NW * 64 * 4;
typedef __attribute__((address_space(3))) unsigned lds_u32;
#define VMW() asm volatile("s_waitcnt vmcnt(0)" ::: "memory")
#define DMA_TILE(Kp_, Pp_, Vp_, k0, kbuf, vbyte) do {                                                                                         \
        _Pragma("unroll") for (int i_ = 0; i_ < 2; ++i_) {                                                                                    \
            __builtin_amdgcn_global_load_lds((const unsigned*)((Kp_) + (size_t)(k0) * LDK + koff[i_]), (lds_u32*)(lds + LDS_K + (kbuf) * SHM_K + (wid + 8 * i_) * 1024), 16, 0, 0);   \
            __builtin_amdgcn_global_load_lds((const unsigned*)((Vp_) + (size_t)(k0) * LDV + voff[i_]), (lds_u32*)(lds + LDS_V + (vbyte) + (wid + 8 * i_) * 1024), 16, 0, 0); }       \
        if (PE) __builtin_amdgcn_global_load_lds((const unsigned*)((Pp_) + (size_t)(k0) * 64 + poff), (lds_u32*)(lds + LDS_K + (kbuf) * SHM_K + SHM_KN + wid * 1024), 16, 0, 0); } while (0)
#define DMA_OFFS()                                                                                                                            \
    int koff[2], voff[2], poff;                                                                                                               \
    _Pragma("unroll") for (int i_ = 0; i_ < 2; ++i_) { const int pc_ = wid + 8 * i_, row_ = pc_ * 4 + (lane >> 4), ch_ = (lane & 15) ^ (row_ & 7); koff[i_] = row_ * LDK + ch_ * 8;   \
        const int sub_ = pc_ * 2 + (lane >> 5), kk_ = (sub_ >> 2) * 8 + ((lane & 31) >> 2), k_ = (kk_ & ~0xC) | ((kk_ & 4) << 1) | ((kk_ & 8) >> 1); voff[i_] = k_ * LDV + (sub_ & 3) * 32 + (lane & 3) * 8; } \
    { const int row_ = wid * 4 + (lane >> 4), c16_ = (lane & 15) ^ (row_ & 7); poff = (row_ + 32 * (c16_ >> 3)) * 64 + (c16_ & 7) * 8; }

template <bool PE, int LDQ, int LDK, int LDV, int LDO>
__device__ __forceinline__ void attn_prime(const BlockRef& cur, int W, char* lds, Seam<PE>& S) {
    int tid_raw = threadIdx.x; asm volatile("" : "+v"(tid_raw));
    const int tid = tid_raw, wid = __builtin_amdgcn_readfirstlane(tid >> 6), lane = tid & 63, r32 = lane & 31, hi = lane >> 5;
    DMA_OFFS();
    const int kb0 = swa_jlo(cur.P0, W) * KVBLK;
    DMA_TILE(cur.K, cur.Kp, cur.V, kb0, 0, 0);
#pragma unroll
    for (int d0 = 0; d0 < 8; ++d0) S.qr[d0] = load8(cur.Q + (size_t)(wid * QBLK + r32) * LDQ + d0 * 16 + hi * 8);
    if (PE) {
#pragma unroll
        for (int d0 = 0; d0 < 4; ++d0) S.qpe[d0] = load8(cur.Q + (size_t)(wid * QBLK + r32) * LDQ + 128 + d0 * 16 + hi * 8); }
    VMW(); __syncthreads();
}
template <bool PE, int LDQ, int LDK, int LDV, int LDO>
__device__ __forceinline__ void attn_block(const BlockRef& cur, const BlockRef& nxt, int skv, int W, char* lds, Seam<PE>& S) {
    int tid_raw = threadIdx.x; asm volatile("" : "+v"(tid_raw));
    const int tid = tid_raw, wid = __builtin_amdgcn_readfirstlane(tid >> 6), lane = tid & 63, r32 = lane & 31, hi = lane >> 5;
    const int j_lo = swa_jlo(cur.P0, W);
    int j_hi = (cur.P0 + QB - 1) / KVBLK + 1; if (j_hi > skv / KVBLK) j_hi = skv / KVBLK;
    const int NT = j_hi - j_lo;
    const int kbn = swa_jlo(nxt.P0, W) * KVBLK;
    const int qlo = cur.P0 + wid * QBLK, qm = qlo + r32 - 4 * hi;
    char* K_lds = lds + LDS_K;
    float* ws = (float*)(lds + LDS_WS) + wid * 64; float* li_l = ws, * al_l = ws + 32;
    char* qpe_l = lds + LDS_QPE + wid * QPE_WAVE + r32 * 144 + hi * 16;
    float m_reg = -1e30f, l_reg = 0; f32x16 o[4] = {};
    DMA_OFFS();
    const int vb0 = (int)(uintptr_t)(lds + LDS_V) + v_rd_base(lane);
    const bf16_t* Kh = cur.K; const bf16_t* Ph = cur.Kp; const bf16_t* Vh = cur.V;
#define RESC(a) do { if (__any((a) < 1.f)) { if (hi == 0) al_l[r32] = (a); asm volatile("s_waitcnt lgkmcnt(0)" ::: "memory");              \
                     for (int d_ = 0; d_ < 4; ++d_) for (int r = 0; r < 16; ++r) o[d_][r] *= al_l[crow(r, hi)]; } } while (0)
#define KBASE(t) ((j_lo + (t)) * KVBLK)
#define MASKT(P0_, P1_, t) do { const int kb_ = KBASE(t); if (kb_ + KVBLK - 1 > qlo || kb_ <= qlo + QBLK - 1 - W) mask_tile(P0_, P1_, qm - kb_, (unsigned)W); } while (0)
#define ROT() do { const int t_ = vs_prev; vs_prev = vs_cur; vs_cur = vs_next; vs_next = t_; } while (0)
    f32x16 pA0, pA1, pB0, pB1; float mnA, mnB, alA, alB; bf16x8 pa0, pa1, pa2, pa3;
    int vs_prev = 2 * SHM_V, vs_cur = 0, vs_next = SHM_V;
    if (PE) {
#pragma unroll
        for (int d0 = 0; d0 < 4; ++d0) *(bf16x8*)(qpe_l + d0 * 32) = S.qpe[d0];
        asm volatile("s_waitcnt lgkmcnt(0)" ::: "memory"); }
    DMA_TILE(Kh, Ph, Vh, KBASE(1), 1, vs_next);
    SBAR(); qkt<0, PE>(pA0, pA1, K_lds, r32, hi, S.qr, qpe_l);
    MASKT(pA0, pA1, 0); partialSM<PE>(pA0, pA1, m_reg, mnA, alA);
    VMW(); __syncthreads(); ROT();
#define STEP(PX0, PX1, mnX, alX, PY0, PY1, alY, t, KB, DMA_ON) do {                                                           \
        if (DMA_ON) DMA_TILE(Kh, Ph, Vh, KBASE((t) + 1), (KB) ^ 1, vs_next);                                                  \
        SBAR(); qkt<KB, PE>(PX0, PX1, K_lds, r32, hi, S.qr, qpe_l);                                                           \
        finishSM(PY0, PY1, alY, l_reg, pa0, pa1, pa2, pa3); SBAR();                                                           \
        pv_tile(o, vb0 + vs_prev, pa0, pa1, pa2, pa3); MASKT(PX0, PX1, (t)); partialSM<PE>(PX0, PX1, m_reg, mnX, alX);        \
        RESC(alX); VMW(); __syncthreads(); ROT(); } while (0)
    for (int t = 1; t + 1 < NT; t += 2) {
        STEP(pB0, pB1, mnB, alB, pA0, pA1, alA, t, 1, true);
        STEP(pA0, pA1, mnA, alA, pB0, pB1, alB, t + 1, 0, true);
    }
    SBAR(); qkt<1, PE>(pB0, pB1, K_lds, r32, hi, S.qr, qpe_l); SBAR();
    finishSM(pA0, pA1, alA, l_reg, pa0, pa1, pa2, pa3); SBAR();
    pv_tile(o, vb0 + vs_prev, pa0, pa1, pa2, pa3);
    MASKT(pB0, pB1, NT - 1); partialSM<PE>(pB0, pB1, m_reg, mnB, alB); RESC(alB);
    finishSM(pB0, pB1, alB, l_reg, pa0, pa1, pa2, pa3); SBAR(); pv_tile(o, vb0 + vs_cur, pa0, pa1, pa2, pa3);
    __syncthreads();
    DMA_TILE(nxt.K, nxt.Kp, nxt.V, kbn, 0, 0);
#pragma unroll
    for (int d0 = 0; d0 < 8; ++d0) S.qr[d0] = load8(nxt.Q + (size_t)(wid * QBLK + r32) * LDQ + d0 * 16 + hi * 8);
    if (PE) {
#pragma unroll
        for (int d0 = 0; d0 < 4; ++d0) S.qpe[d0] = load8(nxt.Q + (size_t)(wid * QBLK + r32) * LDQ + 128 + d0 * 16 + hi * 8); }
    SBAR();
    if (hi == 0) li_l[r32] = l_reg; asm volatile("s_waitcnt lgkmcnt(0)" ::: "memory");
    float rli[16];
#pragma unroll
    for (int r = 0; r < 16; ++r) rli[r] = __builtin_amdgcn_rcpf(li_l[crow(r, hi)]);
    bf16_t* Ow = cur.O + (size_t)(wid * QBLK) * LDO;
#pragma unroll
    for (int r = 0; r < 16; ++r) { const int orow = crow(r, hi);
#pragma unroll
        for (int d0 = 0; d0 < 4; ++d0) { const float v = o[d0][r] * rli[r];
            const float vn = __shfl_xor(v, 1);
            if ((r32 & 1) == 0) *(unsigned*)(Ow + (size_t)orow * LDO + d0 * 32 + r32) = cvtpk(v, vn); } }
    VMW(); __syncthreads();
#undef RESC
#undef KBASE
#undef MASKT
#undef ROT
#undef STEP
}
#undef VMW
#undef DMA_TILE
#undef DMA_OFFS

__device__ __forceinline__ BlockRef mla_ref(int bh, int qb, const bf16_t* Q, const bf16_t* KV, const bf16_t* Kpe, bf16_t* O) {
    const int b = bh >> 2, h = bh & 3; BlockRef r; const size_t row0 = (size_t)b * SEQ;
    r.Q = Q + (row0 + (size_t)qb * QB) * 768 + h * DQK; r.O = O + (row0 + (size_t)qb * QB) * DM + h * DV;
    r.K = KV + row0 * 1024 + h * 256; r.V = r.K + DN; r.Kp = Kpe + row0 * DR; r.P0 = qb * QB; return r;
}
__device__ __forceinline__ void mla_phase(char* lds, const bf16_t* Q, const bf16_t* KV, const bf16_t* Kpe, bf16_t* O) {
    constexpr int NQB = SEQ / QB, NX = NQB / 2, TOTAL = BATCH * NH * NX, W = 1 << 30;
    const int stride = gridDim.x; int L = blockIdx.x; if (L >= TOTAL) return;
#define DEC(L_, bh_, x_) do { const int xcd_ = (L_) & 7, k_ = (L_) >> 3; bh_ = (k_ / NX) * 8 + xcd_; x_ = k_ % NX; } while (0)
    int bh, x; DEC(L, bh, x); int pass = 0;
    BlockRef cur = mla_ref(bh, x, Q, KV, Kpe, O);
    Seam<true> S;
    attn_prime<true, 768, 1024, 1024, DM>(cur, W, lds, S);
    for (;;) {
        const bool more_pass = pass == 0, more_item = L + stride < TOTAL, last = !more_pass && !more_item;
        int bhn = bh, xn = x, passn = pass + 1, Ln = L;
        if (!more_pass) { passn = 0; Ln = more_item ? L + stride : L; DEC(Ln, bhn, xn); }
        const BlockRef nxt = last ? cur : mla_ref(bhn, passn ? NQB - 1 - xn : xn, Q, KV, Kpe, O);
        attn_block<true, 768, 1024, 1024, DM>(cur, nxt, SEQ, W, lds, S);
        if (last) break;
        cur = nxt; bh = bhn; x = xn; pass = passn; L = Ln;
    }
#undef DEC
}
__device__ __forceinline__ BlockRef xa_ref(int L, const bf16_t* Q, const bf16_t* KV, bf16_t* O) {
    const int bh = L & 15, qb = L >> 4, b = bh >> 2, h = bh & 3; BlockRef r; const size_t row0 = (size_t)b * SEQ + (size_t)qb * QB;
    r.Q = Q + row0 * XAW + h * 128; r.O = O + row0 * XAW + h * 128;
    r.K = KV + (size_t)b * MEML * 1024 + h * 128; r.V = r.K + XAW; r.Kp = nullptr; r.P0 = MEML; return r;
}
__device__ __forceinline__ void xa_phase(char* lds, const bf16_t* Q, const bf16_t* KV, bf16_t* O) {
    constexpr int TOTAL = BATCH * NH * (SEQ / QB), W = 1 << 30;
    const int stride = gridDim.x; int L = blockIdx.x; if (L >= TOTAL) return;
    BlockRef cur = xa_ref(L, Q, KV, O);
    Seam<false> S;
    attn_prime<false, XAW, 1024, 1024, XAW>(cur, W, lds, S);
    for (;;) {
        const bool last = L + stride >= TOTAL;
        const BlockRef nxt = last ? cur : xa_ref(L + stride, Q, KV, O);
        attn_block<false, XAW, 1024, 1024, XAW>(cur, nxt, MEML, W, lds, S);
        if (last) break;
        cur = nxt; L += stride;
    }
}
#undef KSWZ
#undef SBAR
}

#define LAS __attribute__((address_space(3)))

constexpr int CW_BAR = 4096;
constexpr int LDS_MISC = LDS_BYTES - 64;
#define XB_TMO      128
#define XB_XCNT(j)  (256  + 64 * (j))
#define XB_XSUB(j)  (1280 + 64 * (j))
#define XB_XGEN(j)  (2304 + 64 * (j))
#define XB_TOP      3328
#define XB_TOPGEN   3392
#define XCD_BAR_WORDS 3456
#define XB_SPIN_CAP (1u << 18)

__device__ __forceinline__ unsigned xb_ld(unsigned* p)              { return __hip_atomic_load(p, __ATOMIC_RELAXED, __HIP_MEMORY_SCOPE_AGENT); }
__device__ __forceinline__ unsigned xb_add(unsigned* p, unsigned v) { return __hip_atomic_fetch_add(p, v, __ATOMIC_RELAXED, __HIP_MEMORY_SCOPE_AGENT); }
__device__ __forceinline__ unsigned xb_xcc_id() { return (unsigned)__builtin_amdgcn_s_getreg((3 << 11) | 20) & 0xFu; }
#define XB_SPIN(cond, bar) do { unsigned _sp = 0; while (cond) { __builtin_amdgcn_s_sleep(1); \
    if ((++_sp & 255u) == 0u) { if (xb_ld(&(bar)[XB_TMO])) break; if (_sp > XB_SPIN_CAP) { atomicAdd(&(bar)[XB_TMO], 1u); break; } } } } while (0)

struct XcdBarrier {
    unsigned* bar; unsigned x;
    volatile LAS unsigned* st;
};

__device__ __forceinline__ XcdBarrier xcd_barrier_post(unsigned* bar, volatile LAS unsigned* st) {
    XcdBarrier b; b.bar = bar; b.x = xb_xcc_id(); b.st = st;
    if (threadIdx.x == 0) (void)xb_add(&bar[XB_XCNT(b.x)], 1u);
    return b;
}
__device__ __forceinline__ void xcd_barrier_complete(unsigned* bar, unsigned x, unsigned& nloc, unsigned& nx) {
    const unsigned G = gridDim.x * gridDim.y * gridDim.z;
    unsigned sum, cnt, mine, sp = 0u;
    for (;;) {
        sum = 0u; cnt = 0u; mine = 0u;
#pragma unroll
        for (unsigned j = 0; j < 16; ++j) { const unsigned c = xb_ld(&bar[XB_XCNT(j)]); sum += c; cnt += (c > 0u) ? 1u : 0u; mine = (j == x) ? c : mine; }
        if (sum == G) break;
        __builtin_amdgcn_s_sleep(1);
        if ((++sp & 255u) == 0u) { if (xb_ld(&bar[XB_TMO])) break; if (sp > XB_SPIN_CAP) { atomicAdd(&bar[XB_TMO], 1u); break; } }
    }
    nloc = mine > 0u ? mine : 1u; nx = cnt > 0u ? cnt : 1u;
}

__device__ __forceinline__ void xcd_barrier(const XcdBarrier& b) {
    asm volatile("s_waitcnt vmcnt(0)" ::: "memory");
    __syncthreads();
    if (threadIdx.x == 0) {
        unsigned* bar = b.bar;
        __builtin_amdgcn_s_waitcnt(0);
        unsigned nloc = b.st[0], nx = b.st[1];
        if (nloc == 0u) { xcd_barrier_complete(bar, b.x, nloc, nx); b.st[0] = nloc; b.st[1] = nx; }
        const unsigned old = xb_add(&bar[XB_XSUB(b.x)], 1u);
        const unsigned gen = old / nloc;
        if (old + 1u == (gen + 1u) * nloc) {
            __builtin_amdgcn_fence(__ATOMIC_RELEASE, "agent");
            asm volatile("s_waitcnt vmcnt(0)" ::: "memory");
            const unsigned og = xb_add(&bar[XB_TOP], 1u);
            const unsigned tg = og / nx;
            if (og + 1u == (tg + 1u) * nx) xb_add(&bar[XB_TOPGEN], 1u);
            else XB_SPIN(xb_ld(&bar[XB_TOPGEN]) == tg, bar);
            __builtin_amdgcn_fence(__ATOMIC_ACQUIRE, "agent");
            xb_add(&bar[XB_XGEN(b.x)], 1u);
            asm volatile("s_waitcnt vmcnt(0)" ::: "memory");
        } else {
            XB_SPIN(xb_ld(&bar[XB_XGEN(b.x)]) == gen, bar);
            __builtin_amdgcn_fence(__ATOMIC_ACQUIRE, "agent");
            asm volatile("s_waitcnt vmcnt(0)" ::: "memory");
        }
    }
    __syncthreads();
}

constexpr size_t WB_GU1 = 16 * MiB, WB_GU2 = 27 * MiB, WB_DN1 = 38 * MiB, WB_DN2 = WB_DN1 + 5767168, WB_IN = 49 * MiB, WB_UQ = WB_IN + 3670016,
                 WB_UKV = WB_UQ + 786432, WB_OUT = 54 * MiB, WB_XQ = 56 * MiB, WB_XKV = 57 * MiB, WB_XO = 59 * MiB;
constexpr int NIN = 1792;

template <class DST>
__device__ __forceinline__ void transpose_items(const float* W, int K, int N, const float* gk, bf16_t* WT, DST dst, LAS float* scr, int worker, int nworkers, int lane) {
    const int nblk = N / 32, nitems = (K / 64) * nblk;
    for (int item = worker; item < nitems; item += nworkers) {
        const int kb = item / nblk, nb = item % nblk, k0 = 64 * kb, n0 = 32 * nb;
#pragma unroll 8
        for (int i = 0; i < 32; ++i) { const int kk = 2 * i + (lane >> 5); float w = W[(size_t)(k0 + kk) * N + n0 + (lane & 31)]; if (gk) w *= gk[k0 + kk]; scr[kk * 33 + (lane & 31)] = w; }
        asm volatile("s_waitcnt lgkmcnt(0)" ::: "memory");
        const int cc = lane & 7;
#pragma unroll
        for (int j = 0; j < 4; ++j) { const int n = (lane >> 3) + 8 * j; const LAS float* s = scr + (8 * cc) * 33 + n;
            u32x4 o; o.x = pk2(s[0 * 33], s[1 * 33]); o.y = pk2(s[2 * 33], s[3 * 33]); o.z = pk2(s[4 * 33], s[5 * 33]); o.w = pk2(s[6 * 33], s[7 * 33]);
            *(u32x4*)(WT + (size_t)dst(n0 + n) * K + k0 + 8 * cc) = o; }
        asm volatile("s_waitcnt lgkmcnt(0)" ::: "memory");
    }
}
__device__ __forceinline__ void nrope_kpe(const bf16_t* kper, bf16_t* kpe, const float* cosT, const float* sinT, const Ctx& c) {
    for (int i = c.gt; i < T * 32; i += c.ngt) {
        const int k = i & 31, row = i >> 5;
        const float cs = cosT[i], sn = sinT[i];
        const bf16_t* s = kper + (size_t)row * 64; const float x1 = bf2f(s[k]), x2 = bf2f(s[k + 32]);
        bf16_t* o = kpe + (size_t)row * 64; o[k] = (bf16_t)f2bf(x1 * cs - x2 * sn); o[k + 32] = (bf16_t)f2bf(x2 * cs + x1 * sn);
    }
}

#define MKCTX() int tid_ = threadIdx.x; asm volatile("" : "+v"(tid_)); Ctx c; c.tid = tid_; c.lane = c.tid & 63; c.wave = __builtin_amdgcn_readfirstlane(c.tid >> 6); \
    c.gw = blockIdx.x * NWAVES + c.wave; c.ngw = gridDim.x * NWAVES; c.gt = blockIdx.x * NTHREADS + c.tid; c.ngt = gridDim.x * NTHREADS; float* wl = (float*)lds + c.wave * 256; (void)wl
enum Step { ST_PREP = 0, ST_GU1, ST_DN1, ST_RN1, ST_WIN, ST_QG, ST_KVG, ST_KPE, ST_LRU, ST_MIX, ST_WOUT, ST_RN2, ST_XQ, ST_MEMKV, ST_XATT, ST_XO, ST_RN3, ST_GU2, ST_DN2, ST_RN4, ST_END };

template <int STEP>
__device__ __forceinline__ void do_step(const Params& p, unsigned char* lds) {
    constexpr int step = STEP;
    const int G = gridDim.x, bid = blockIdx.x;
    unsigned char* ws = p.ws;
    float* rs0 = (float*)(ws + WS_RS); float* rs1 = rs0 + T; float* rs2 = rs1 + T; float* rs3 = rs2 + T;
    float* ssq_q = (float*)(ws + WS_SSQQ); float* ssq_kv = (float*)(ws + WS_SSQKV);
    float* cosT = (float*)(ws + WS_COS); float* sinT = (float*)(ws + WS_SIN);
    bf16_t* memn = (bf16_t*)(ws + WS_MEMN); bf16_t* memkv = (bf16_t*)(ws + WS_MEMKV);
    bf16_t* xb = (bf16_t*)(ws + WS_XB); bf16_t* hid = (bf16_t*)(ws + WS_HID);
    bf16_t* cq = (bf16_t*)(ws + WS_CQ); bf16_t* ckv = (bf16_t*)(ws + WS_CKV); bf16_t* kper = (bf16_t*)(ws + WS_KPER); bf16_t* ub = (bf16_t*)(ws + WS_U); bf16_t* gateb = (bf16_t*)(ws + WS_GATE);
    bf16_t* Qb = (bf16_t*)(ws + WS_Q); bf16_t* kpe = (bf16_t*)(ws + WS_KPE); bf16_t* KVb = (bf16_t*)(ws + WS_KV);
    bf16_t* qx = (bf16_t*)(ws + WS_QX); bf16_t* ox = (bf16_t*)(ws + WS_OX); bf16_t* ycat = (bf16_t*)(ws + WS_YCAT);
    float* YA = (float*)(ws + WS_YA); float* YB = (float*)(ws + WS_YB);
    LAS unsigned char* ldsl = (LAS unsigned char*)lds;
        switch (step) {
        case ST_PREP: { MKCTX();
            nrow_prep(p.in[I_X], xb, rs0, T, c);
            nrow_memn(p.in[I_MEM], p.in[I_MEMG], memn, c);
            nrope_tables((const int*)p.in[I_POS], cosT, sinT, c);
            LAS float* scr = (LAS float*)(ldsl + c.wave * 16384);
            int off = 0;
#define TR(W, K, N, GK, DSTP, ...) do { transpose_items(W, K, N, GK, (bf16_t*)(ws + (DSTP)), __VA_ARGS__, scr, (c.gw + c.ngw - (off % c.ngw)) % c.ngw, c.ngw, c.lane); off += ((K) / 64) * ((N) / 32); } while (0)
            auto dgu = [](int n) { const int j = n < DFF ? n : n - DFF; return 256 * (j >> 7) + (n < DFF ? 0 : 128) + (j & 127); };
            auto did = [](int n) { return n; };
            auto din = [](int n) { return n < 704 ? n : n + 64; };
            auto duq = [](int n) { const int h = n / DQK, d = n % DQK; return d < DN ? h * DN + d : (d < DN + 32 ? 512 + 32 * h + (d - DN) : 640 + 32 * h + (d - DN - 32)); };
            TR(p.in[I_F1GU], DM, 2 * DFF, p.in[I_F1PRE], WB_GU1, dgu);
            TR(p.in[I_F2GU], DM, 2 * DFF, p.in[I_F2PRE], WB_GU2, dgu);
            TR(p.in[I_F1DN], DFF, DM, nullptr, WB_DN1, did);
            TR(p.in[I_F2DN], DFF, DM, nullptr, WB_DN2, did);
            TR(p.in[I_WIN], DM, INC, p.in[I_MIXPRE], WB_IN, din);
            TR(p.in[I_WUQ], QLR, NH * DQK, p.in[I_QAG], WB_UQ, duq);
            TR(p.in[I_WUKV], KVLR, NH * 256, p.in[I_KVAG], WB_UKV, did);
            TR(p.in[I_WOUT], DM, DM, nullptr, WB_OUT, did);
            TR(p.in[I_XAWQ], DM, XAW, p.in[I_XAPRE], WB_XQ, did);
            TR(p.in[I_XAWKV], DM, 2 * XAW, nullptr, WB_XKV, did);
            TR(p.in[I_XAWO], XAW, DM, nullptr, WB_XO, did);
#undef TR
            { u32x4* z = (u32x4*)(ws + WB_IN + (size_t)704 * DM * 2); for (int i = c.gt; i < 64 * DM * 2 / 16; i += c.ngt) z[i] = (u32x4){0u, 0u, 0u, 0u}; }
        } break;
        case ST_GU1: case ST_GU2: {
            const bool f1 = step == ST_GU1;
            pg8::Gemm g{xb, (const bf16_t*)(ws + (f1 ? WB_GU1 : WB_GU2)), T, 2 * DFF, DM}; pg8::StaticOrder S; S.init(T, 2 * DFF, G, bid);
            pg8::EpiSwiGLU E{hid, DFF, f1 ? rs0 : rs3};
            pg8::gemm_phase<pg8::EpiSwiGLU, pg8::StaticOrder, true, true>(ldsl, g, S, E);
        } break;
        case ST_DN1: case ST_WOUT: case ST_XO: case ST_DN2: {
            const bf16_t* A = (step == ST_WOUT) ? ycat : (step == ST_XO) ? ox : hid;
            const size_t wb = (step == ST_DN1) ? WB_DN1 : (step == ST_DN2) ? WB_DN2 : (step == ST_WOUT) ? WB_OUT : WB_XO;
            const int K = (step == ST_WOUT) ? DM : (step == ST_XO) ? XAW : DFF;
            float* Y = (step == ST_DN1 || step == ST_DN2) ? YA : YB;
            pg8::Gemm g{A, (const bf16_t*)(ws + wb), T, DM, K}; pg8::StaticOrder S; S.init(T, DM, G, bid);
            pg8::EpiF32 E{Y, DM};
            pg8::gemm_phase<pg8::EpiF32, pg8::StaticOrder, true, true>(ldsl, g, S, E);
        } break;
        case ST_RN1: case ST_RN2: case ST_RN3: case ST_RN4: { MKCTX();
            const float* base = (step == ST_RN1) ? p.in[I_X] : p.out;
            const float* y = (step == ST_RN1 || step == ST_RN4) ? YA : YB;
            const float* g = p.in[(step == ST_RN1) ? I_F1POST : (step == ST_RN2) ? I_MIXPOST : (step == ST_RN3) ? I_XAPOST : I_F2POST];
            const float coef = (step == ST_RN1 || step == ST_RN4) ? 0.5f : 1.0f;
            float* rso = (step == ST_RN1) ? rs1 : (step == ST_RN2) ? rs2 : (step == ST_RN3) ? rs3 : rs0;
            nrow_resnorm(base, y, g, coef, p.out, xb, rso, c);
        } break;
        case ST_WIN: {
            pg8::Gemm g{xb, (const bf16_t*)(ws + WB_IN), T, NIN, DM}; pg8::StaticOrder S; S.init(T, NIN, G, bid);
            pg8::EpiWin E{cq, ckv, kper, ub, gateb, rs1, ssq_q, ssq_kv};
            pg8::gemm_phase<pg8::EpiWin, pg8::StaticOrder, true, true>(ldsl, g, S, E);
        } break;
        case ST_QG: {
            pg8::Gemm g{cq, (const bf16_t*)(ws + WB_UQ), T, NH * DQK, QLR}; pg8::StaticOrder S; S.init(T, NH * DQK, G, bid);
            pg8::EpiQ E{Qb, ssq_q, cosT, sinT};
            pg8::gemm_phase<pg8::EpiQ, pg8::StaticOrder, true, true>(ldsl, g, S, E);

        } break;
        case ST_KVG: case ST_XQ: case ST_MEMKV: {
            const bf16_t* A = (step == ST_KVG) ? ckv : (step == ST_XQ) ? xb : memn;
            const size_t wb = (step == ST_KVG) ? WB_UKV : (step == ST_XQ) ? WB_XQ : WB_XKV;
            const int M = (step == ST_MEMKV) ? MT : T, N = (step == ST_XQ) ? XAW : 1024, K = (step == ST_KVG) ? KVLR : DM;
            bf16_t* O = (step == ST_KVG) ? KVb : (step == ST_XQ) ? qx : memkv;
            pg8::Gemm g{A, (const bf16_t*)(ws + wb), M, N, K}; pg8::StaticOrder S; S.init(M, N, G, bid);
            pg8::EpiRowScale E{O, N, (step == ST_KVG) ? 2 : (step == ST_XQ) ? 1 : 0, (step == ST_KVG) ? ssq_kv : rs2, 8, 1.0f / KVLR};
            pg8::gemm_phase<pg8::EpiRowScale, pg8::StaticOrder, true, true>(ldsl, g, S, E);

        } break;
        case ST_KPE: { MKCTX(); nrope_kpe(kper, kpe, cosT, sinT, c); } break;
        case ST_LRU: { MKCTX();
            if (c.wave == 0 && bid < 32)
                nlru(ub, gateb, p.in[I_CONVW], p.in[I_CONVB], p.in[I_RGWA], p.in[I_RGBA], p.in[I_RGWX], p.in[I_RGBX], p.in[I_LAM], ycat, bid, c.lane);
        } break;
        case ST_MIX: att::mla_phase((char*)lds, Qb, KVb, kpe, ycat); break;
        case ST_XATT: att::xa_phase((char*)lds, qx, memkv, ox); break;
        default: break;
        }
}
__device__ __forceinline__ constexpr bool step_sync(int s) { return !(s == ST_QG || s == ST_KVG || s == ST_XQ || s == ST_LRU || s == ST_END - 1); }
template <int STEP> __device__ __forceinline__ void run_steps(const Params& p, unsigned char* lds, cg::grid_group& grid, const XcdBarrier& bar) {
    if constexpr (STEP < ST_END) {
        do_step<STEP>(p, lds);
        if constexpr (step_sync(STEP)) { if constexpr (STEP == ST_PREP) grid.sync(); else xcd_barrier(bar); }
        run_steps<STEP + 1>(p, lds, grid, bar);
    }
}
__global__ void __launch_bounds__(NTHREADS, 2) fwd_kernel(Params p) {
    cg::grid_group grid = cg::this_grid();
    extern __shared__ __attribute__((aligned(16))) unsigned char lds[];
    volatile LAS unsigned* misc = (volatile LAS unsigned*)((LAS unsigned char*)lds + LDS_MISC);
    if (threadIdx.x < 16) misc[threadIdx.x] = 0u;
    __syncthreads();
    const XcdBarrier bar = xcd_barrier_post((unsigned*)(p.ws + WS_CTL) + CW_BAR, misc);
    run_steps<0>(p, lds, grid, bar);
}

extern "C" void kernel_launch(void* const* d_in, const int* in_sizes, int n_in, void* d_out, int out_size, void* d_ws, size_t ws_size, hipStream_t stream) {
    static int grid_blocks = 0;
    if (grid_blocks == 0) {
        if (n_in != 32 || out_size != T * DM || ws_size < WS_END) { fprintf(stderr, "kernel_launch: unexpected shapes (n_in %d out %d ws %zu)\n", n_in, out_size, ws_size); grid_blocks = -1; return; }
        int dev = 0, cus = 0, per_cu = 0;
        (void)hipGetDevice(&dev);
        (void)hipDeviceGetAttribute(&cus, hipDeviceAttributeMultiprocessorCount, dev);
        (void)hipFuncSetAttribute((const void*)fwd_kernel, hipFuncAttributeMaxDynamicSharedMemorySize, LDS_BYTES);
        (void)hipOccupancyMaxActiveBlocksPerMultiprocessor(&per_cu, (const void*)fwd_kernel, NTHREADS, LDS_BYTES);
        if (per_cu < 1) { fprintf(stderr, "kernel_launch: occupancy query says %d blocks per CU\n", per_cu); per_cu = 1; }
        if (per_cu > 1) per_cu = 1;
        grid_blocks = cus * per_cu;
        (void)hipGetLastError();
    }
    if (grid_blocks < 0) return;
    (void)hipMemsetAsync((char*)d_ws + WS_CTL, 0, CTL_ZERO_BYTES, stream);
    Params p{};
    for (int i = 0; i < 32; ++i) p.in[i] = (const float*)d_in[i];
    p.out = (float*)d_out; p.ws = (unsigned char*)d_ws;
    void* args[] = {&p};
    hipError_t e = hipLaunchCooperativeKernel((const void*)fwd_kernel, dim3(grid_blocks), dim3(NTHREADS), args, LDS_BYTES, stream);
    if (e != hipSuccess) fprintf(stderr, "cooperative launch failed: %s (grid %d)\n", hipGetErrorString(e), grid_blocks);
}
```

```cpp
#include <hip/hip_runtime.h>
#include <hip/hip_cooperative_groups.h>
#include <cstdio>
#include <cstdint>
namespace cg = cooperative_groups;

typedef unsigned short bf16_t;
typedef short bf16x8 __attribute__((ext_vector_type(8)));
typedef float f32x4 __attribute__((ext_vector_type(4)));
typedef float f32x16 __attribute__((ext_vector_type(16)));
typedef unsigned u32x2 __attribute__((ext_vector_type(2)));
typedef unsigned u32x4 __attribute__((ext_vector_type(4)));

constexpr int BATCH = 4, SEQ = 8192, T = BATCH * SEQ, DM = 1024, MEML = 256, MT = BATCH * MEML;
constexpr int NH = 4, DN = 128, DR = 64, DQK = 192, DV = 128, QLR = 384, KVLR = 256;
constexpr int LRUW = 512, NBLK = 8, BD = 64, INC = 1728, DFF = 2816;
constexpr int XAW = 512;
constexpr float EPS = 1e-6f;
constexpr int NTHREADS = 512, NWAVES = 8;
constexpr int LDS_BYTES = 147456;

constexpr size_t MiB = 1u << 20;
constexpr size_t WS_CTL = 0, CTL_ZERO_BYTES = 1 * MiB;
constexpr size_t WS_RS = 1 * MiB;
constexpr size_t WS_SSQQ = 2 * MiB;
constexpr size_t WS_SSQKV = 4 * MiB;
constexpr size_t WS_LRUSUM = 5 * MiB;
constexpr size_t WS_COS = 8 * MiB, WS_SIN = 12 * MiB;
constexpr size_t WS_W = 16 * MiB;
constexpr size_t WS_MEMN = 60 * MiB, WS_MEMKV = 62 * MiB;
constexpr size_t WS_XB = 64 * MiB;
constexpr size_t WS_HID = 128 * MiB;
constexpr size_t WS_CQ = 128 * MiB, WS_CKV = 152 * MiB, WS_KPER = 168 * MiB, WS_U = 172 * MiB, WS_GATE = 204 * MiB, WS_Q = 236 * MiB, WS_KPE = 284 * MiB;
constexpr size_t WS_KV = 304 * MiB, WS_QX = 304 * MiB, WS_OX = 336 * MiB;
constexpr size_t WS_YCAT = 368 * MiB;
constexpr size_t WS_LRUH = 432 * MiB, WS_LRUP = 464 * MiB;
constexpr size_t WS_YA = 304 * MiB, WS_YB = 128 * MiB;
constexpr size_t WS_END = 512 * MiB;

struct Params { const float* in[32]; float* out; unsigned char* ws; };
enum { I_X = 0, I_MEM, I_POS, I_F1PRE, I_F1GU, I_F1DN, I_F1POST, I_MIXPRE, I_WIN, I_QAG, I_WUQ, I_KVAG, I_WUKV, I_CONVW, I_CONVB,
       I_RGWA, I_RGBA, I_RGWX, I_RGBX, I_LAM, I_WOUT, I_MIXPOST, I_XAPRE, I_MEMG, I_XAWQ, I_XAWKV, I_XAWO, I_XAPOST, I_F2PRE, I_F2GU, I_F2DN, I_F2POST };

struct Ctx { int tid, lane, wave, gw, ngw, gt, ngt; };

__device__ __forceinline__ float bf2f(bf16_t v) { return __uint_as_float((unsigned)v << 16); }
__device__ __forceinline__ float bfs(short v) { return __uint_as_float(((unsigned)(unsigned short)v) << 16); }
__device__ __forceinline__ unsigned f2bf(float f) { unsigned u = __float_as_uint(f); return (u + 0x7fffu + ((u >> 16) & 1u)) >> 16; }
__device__ __forceinline__ unsigned pk2(float lo, float hi) { return f2bf(lo) | (f2bf(hi) << 16); }
__device__ __forceinline__ float wave_sum(float v) {
#pragma unroll
    for (int o = 1; o < 64; o <<= 1) v += __shfl_xor(v, o);
    return v;
}
__device__ __forceinline__ float wave_max(float v) {
#pragma unroll
    for (int o = 1; o < 64; o <<= 1) v = fmaxf(v, __shfl_xor(v, o));
    return v;
}
__device__ __forceinline__ float sigmoidf_(float x) { return 1.0f / (1.0f + __expf(-x)); }
__device__ __forceinline__ float siluf_(float x) { return x / (1.0f + __expf(-x)); }
__device__ __forceinline__ float gelu_tanh(float x) { const float u = 0.7978845608028654f * (x + 0.044715f * x * x * x); return 0.5f * x * (1.0f + tanhf(u)); }
__device__ __forceinline__ int crow(int r, int hi) { return (r & 3) + 8 * (r >> 2) + 4 * hi; }

namespace pg8 {
#define PG8_LAS __attribute__((address_space(3)))
typedef unsigned short bf16_t;
typedef short bf16x8 __attribute__((ext_vector_type(8)));
typedef float f32x4 __attribute__((ext_vector_type(4)));
typedef unsigned u32x4 __attribute__((ext_vector_type(4)));
constexpr int BM = 256, BK = 64, HALF = 128, HTB = HALF * BK * 2  , STAGE_BYTES = 8 * HTB, NXCD = 8, WGM = 8;

__host__ __device__ __forceinline__ int lds_byte(int r, int c) { const int st = (r >> 4) * 2 + (c >> 5), rr = r & 15, cc = c & 31, ob = rr * 64 + cc * 2; return st * 1024 + (ob ^ (((ob >> 9) & 1) << 5)); }
__host__ __device__ __forceinline__ void stage_rc(int b, int& R, int& C) { const int st = b / 1024, sb = b % 1024, swz = sb ^ (((sb >> 9) & 1) << 5); R = (st >> 1) * 16 + swz / 64; C = (st & 1) * 32 + (swz % 64) / 2; }
__host__ __device__ __forceinline__ int perm32(int rho) { const int n = rho >> 4, i = rho & 15; return 8 * (i >> 2) + 4 * n + (i & 3); }

struct Unit { int pm, pn; };
struct Gemm { const bf16_t* A; const bf16_t* Bt; int M, N, K; };

struct StaticOrder {
    int nM, nN, nwg, G, c;
    __host__ __device__ void init(int M, int N, int G_, int c_) { nM = M / BM; nN = N / BM; nwg = nM * nN; G = G_; c = c_; }
    __host__ __device__ bool next(int i, Unit& u) const {
        const long L = (long)i * G + c; if (L >= nwg) return false;
        int wgid = (int)L; { const int q = nwg / NXCD, r = nwg % NXCD, xcd = wgid % NXCD, off = wgid / NXCD; wgid = (xcd < r ? xcd * (q + 1) : r * (q + 1) + (xcd - r) * q) + off; }
        const int nig = WGM * nN, gid = wgid / nig, fm = gid * WGM, gsz = (nM - fm) < WGM ? (nM - fm) : WGM;
        u.pm = fm + ((wgid % nig) % gsz); u.pn = (wgid % nig) / gsz; return true;
    }
    __device__ __forceinline__ void a_ready(const Unit&) const {}
    __device__ __forceinline__ void done(const Unit&) const {}
};

__device__ __forceinline__ unsigned cvt_pk_bf16(float lo, float hi) { unsigned r; asm volatile("v_cvt_pk_bf16_f32 %0, %1, %2" : "=v"(r) : "v"(lo), "v"(hi)); return r; }
typedef float f32x2 __attribute__((ext_vector_type(2)));

__device__ __forceinline__ u32x4 pack8s(f32x4 a, f32x4 b, float s) { u32x4 w; w.x = cvt_pk_bf16(a[0] * s, a[1] * s); w.y = cvt_pk_bf16(a[2] * s, a[3] * s); w.z = cvt_pk_bf16(b[0] * s, b[1] * s); w.w = cvt_pk_bf16(b[2] * s, b[3] * s); return w; }
__device__ __forceinline__ float silu_f(float x) { return x * __builtin_amdgcn_rcpf(1.0f + __expf(-x)); }

struct EpiF32 {
    static constexpr bool PERM = false, AFTER_DRAIN = false;
    float* C; int ldc;
    __device__ __forceinline__ void operator()(const f32x4 (&acc)[2][2][4][2], const Unit& u, int wr, int wc, int fr, int fq) const {
        const int row0 = u.pm * BM + wr * 64 + fr, col0 = u.pn * BM + wc * 32 + 4 * fq;
#pragma unroll
        for (int ai = 0; ai < 2; ++ai)
#pragma unroll
            for (int m = 0; m < 4; ++m) { float* rowp = C + (size_t)(row0 + ai * HALF + m * 16) * ldc + col0;
#pragma unroll
                for (int bj = 0; bj < 2; ++bj)
#pragma unroll
                    for (int n = 0; n < 2; ++n) *(f32x4*)(rowp + bj * HALF + n * 16) = acc[ai][bj][m][n]; }
    }
};
struct EpiSwiGLU {
    static constexpr bool PERM = true, AFTER_DRAIN = false;
    bf16_t* H; int ldh; const float* rs;
    __device__ __forceinline__ void operator()(const f32x4 (&acc)[2][2][4][2], const Unit& u, int wr, int wc, int fr, int fq) const {
        const int row0 = u.pm * BM + wr * 64 + fr, col0 = u.pn * HALF + wc * 32 + 8 * fq;
#pragma unroll
        for (int ai = 0; ai < 2; ++ai)
#pragma unroll
            for (int m = 0; m < 4; ++m) { const int row = row0 + ai * HALF + m * 16; const float s = rs[row];
                float h[8];
#pragma unroll
                for (int n = 0; n < 2; ++n)
#pragma unroll
                    for (int e = 0; e < 4; ++e) h[n * 4 + e] = silu_f(acc[ai][0][m][n][e] * s) * (acc[ai][1][m][n][e] * s);
                u32x4 w; w.x = cvt_pk_bf16(h[0], h[1]); w.y = cvt_pk_bf16(h[2], h[3]); w.z = cvt_pk_bf16(h[4], h[5]); w.w = cvt_pk_bf16(h[6], h[7]);
                *(u32x4*)(H + (size_t)row * ldh + col0) = w; }
    }
};
struct EpiRowScale {
    static constexpr bool PERM = true, AFTER_DRAIN = false;
    bf16_t* O; int ldc; int mode; const float* sc; int nslot; float inv_dim;
    __device__ __forceinline__ void operator()(const f32x4 (&acc)[2][2][4][2], const Unit& u, int wr, int wc, int fr, int fq) const {
        const int row0 = u.pm * BM + wr * 64 + fr, col0 = u.pn * BM + wc * 32 + 8 * fq;
#pragma unroll
        for (int ai = 0; ai < 2; ++ai)
#pragma unroll
            for (int m = 0; m < 4; ++m) { const int row = row0 + ai * HALF + m * 16; float s = 1.0f;
                if (mode == 1) s = sc[row];
                else if (mode == 2) { float t = 0.f; const f32x4* sp = (const f32x4*)(sc + (size_t)row * nslot);
                    for (int k = 0; k < nslot / 4; ++k) { const f32x4 q = sp[k]; t += (q[0] + q[1]) + (q[2] + q[3]); }
                    s = rsqrtf(t * inv_dim + EPS); }
                bf16_t* rowp = O + (size_t)row * ldc + col0;
#pragma unroll
                for (int bj = 0; bj < 2; ++bj) *(u32x4*)(rowp + bj * HALF) = pack8s(acc[ai][bj][m][0], acc[ai][bj][m][1], s); }
    }
};
struct EpiWin {
    static constexpr bool PERM = true, AFTER_DRAIN = false;
    bf16_t *cq, *ckv, *kper, *ub, *gate; const float* rs; float *ssq_q, *ssq_kv;
    __device__ __forceinline__ void operator()(const f32x4 (&acc)[2][2][4][2], const Unit& u, int wr, int wc, int fr, int fq) const {
        const int row0 = u.pm * BM + wr * 64 + fr, cl = wc * 32 + 8 * fq;
#pragma unroll
        for (int ai = 0; ai < 2; ++ai)
#pragma unroll
            for (int m = 0; m < 4; ++m) { const int row = row0 + ai * HALF + m * 16; const float s = rs[row];
#pragma unroll
                for (int bj = 0; bj < 2; ++bj) { const int hb = 2 * u.pn + bj;
                    const f32x4 v0 = acc[ai][bj][m][0] * s, v1 = acc[ai][bj][m][1] * s;
                    bf16_t* dst;
                    if (hb < 3) dst = cq + (size_t)row * 384 + hb * 128 + cl;
                    else if (hb < 5) dst = ckv + (size_t)row * 256 + (hb - 3) * 128 + cl;
                    else if (hb == 5) dst = (wc < 2) ? kper + (size_t)row * 64 + cl : nullptr;
                    else if (hb < 10) dst = ub + (size_t)row * 512 + (hb - 6) * 128 + cl;
                    else dst = gate + (size_t)row * 512 + (hb - 10) * 128 + cl;
                    if (dst) *(u32x4*)dst = pack8s(v0, v1, 1.0f);
                    if (hb < 5) { float q = (v0[0] * v0[0] + v0[1] * v0[1]) + (v0[2] * v0[2] + v0[3] * v0[3]) + (v1[0] * v1[0] + v1[1] * v1[1]) + (v1[2] * v1[2] + v1[3] * v1[3]);
                        q += __shfl_xor(q, 16); q += __shfl_xor(q, 32);
                        if (fq == 0) { if (hb < 3) ssq_q[(size_t)row * 12 + hb * 4 + wc] = q; else ssq_kv[(size_t)row * 8 + (hb - 3) * 4 + wc] = q; } } } }
    }
};
struct EpiQ {
    static constexpr bool PERM = true, AFTER_DRAIN = false;
    bf16_t* Q; const float* ssq; const float* cosT; const float* sinT;
    __device__ __forceinline__ void operator()(const f32x4 (&acc)[2][2][4][2], const Unit& u, int wr, int wc, int fr, int fq) const {
        const int row0 = u.pm * BM + wr * 64 + fr;
#pragma unroll
        for (int ai = 0; ai < 2; ++ai)
#pragma unroll
            for (int m = 0; m < 4; ++m) { const int row = row0 + ai * HALF + m * 16;
                const f32x4* sp = (const f32x4*)(ssq + (size_t)row * 12); const f32x4 q0 = sp[0], q1 = sp[1], q2 = sp[2];
                const float t = ((q0[0] + q0[1]) + (q0[2] + q0[3])) + ((q1[0] + q1[1]) + (q1[2] + q1[3])) + ((q2[0] + q2[1]) + (q2[2] + q2[3]));
                const float s = rsqrtf(t * (1.0f / 384.0f) + EPS);
                bf16_t* qrow = Q + (size_t)row * 768;
                if (u.pn < 2) {
#pragma unroll
                    for (int bj = 0; bj < 2; ++bj) *(u32x4*)(qrow + (2 * u.pn + bj) * 192 + wc * 32 + 8 * fq) = pack8s(acc[ai][bj][m][0], acc[ai][bj][m][1], s);
                } else {
                    const f32x4 c0 = *(const f32x4*)(cosT + (size_t)row * 32 + 8 * fq), c1 = *(const f32x4*)(cosT + (size_t)row * 32 + 8 * fq + 4);
                    const f32x4 s0 = *(const f32x4*)(sinT + (size_t)row * 32 + 8 * fq), s1 = *(const f32x4*)(sinT + (size_t)row * 32 + 8 * fq + 4);
                    const f32x4 xa0 = acc[ai][0][m][0] * s, xa1 = acc[ai][0][m][1] * s, xb0 = acc[ai][1][m][0] * s, xb1 = acc[ai][1][m][1] * s;
                    const f32x4 o10 = xa0 * c0 - xb0 * s0, o11 = xa1 * c1 - xb1 * s1, o20 = xb0 * c0 + xa0 * s0, o21 = xb1 * c1 + xa1 * s1;
                    *(u32x4*)(qrow + wc * 192 + 128 + 8 * fq) = pack8s(o10, o11, 1.0f);
                    *(u32x4*)(qrow + wc * 192 + 160 + 8 * fq) = pack8s(o20, o21, 1.0f);
                } }
    }
};
template <class Epi, class Sched, bool ALIGN_EPI = false, bool SP2 = false>
__device__ __forceinline__ void gemm_phase(PG8_LAS unsigned char* lds, const Gemm g, const Sched& S, const Epi& E) {
    int tid_raw = threadIdx.x; asm volatile("" : "+v"(tid_raw));
    const int tid = tid_raw, wid = __builtin_amdgcn_readfirstlane(tid >> 6), lane = tid & 63, wr = wid >> 2, wc = wid & 3, fr = lane & 15, fq = lane >> 4;
    int K = g.K; asm volatile("" : "+s"(K));
    const int nt = K / BK;
    unsigned voffA[2], voffB[2];
#pragma unroll
    for (int i = 0; i < 2; ++i) { int R, C; stage_rc(tid * 16 + i * 8192, R, C); const int Rb = Epi::PERM ? ((R & ~31) + perm32(R & 31)) : R;
        voffA[i] = (unsigned)(R * K + C) * 2u; voffB[i] = (unsigned)(Rb * K + C) * 2u; }
    const size_t kstep = (size_t)(BK * 2);
    const size_t hstep = (size_t)HALF * K * 2;
    const size_t tstep = 2 * hstep;
    const unsigned ldsw = (unsigned)wid * 1024u;
    const int aoff = lds_byte(wr * 64 + fr, fq * 8), boff = lds_byte(wc * 32 + fr, fq * 8);
#define PG8_SA(b, h) (((b) * 2 + (h)) * HTB)
#define PG8_SB(b, h) ((4 + (b) * 2 + (h)) * HTB)
#define PG8_STAGE(bufoff, gbase, voff) do { _Pragma("unroll") for (int _i = 0; _i < 2; ++_i) \
        __builtin_amdgcn_global_load_lds((const unsigned*)((const char*)(gbase) + (voff)[_i]), (PG8_LAS unsigned*)(lds + (bufoff) + ldsw + _i * 8192), 16, 0, 0); } while (0)
#define PG8_LDA(dst, b, h) do { _Pragma("unroll") for (int m = 0; m < 4; ++m) _Pragma("unroll") for (int k = 0; k < 2; ++k) dst[m][k] = *(const PG8_LAS bf16x8*)(lds + PG8_SA(b, h) + aoff + m * 2048 + k * 1024); } while (0)
#define PG8_LDB(dst, b, h) do { _Pragma("unroll") for (int n = 0; n < 2; ++n) _Pragma("unroll") for (int k = 0; k < 2; ++k) dst[n][k] = *(const PG8_LAS bf16x8*)(lds + PG8_SB(b, h) + boff + n * 2048 + k * 1024); } while (0)
#define PG8_MMA(ai, bj, At, Bt) do { __builtin_amdgcn_s_setprio(1); _Pragma("unroll") for (int m = 0; m < 4; ++m) _Pragma("unroll") for (int n = 0; n < 2; ++n) _Pragma("unroll") for (int k = 0; k < 2; ++k) \
        acc[ai][bj][m][n] = __builtin_amdgcn_mfma_f32_16x16x32_bf16(Bt[n][k], At[m][k], acc[ai][bj][m][n], 0, 0, 0); __builtin_amdgcn_s_setprio(0); } while (0)
#define PG8_WAIT_V(n) asm volatile("s_waitcnt vmcnt(" #n ")" ::: "memory")
#define PG8_WAIT_L(n) asm volatile("s_waitcnt lgkmcnt(" #n ")" ::: "memory")
#define PG8_BAR __builtin_amdgcn_s_barrier()
#define PG8_SCHED __builtin_amdgcn_sched_barrier(0)
    Unit cur, nxt; int ui = 0;
    if (!S.next(0, cur)) return;
    f32x4 acc[2][2][4][2];
#pragma unroll
    for (int a = 0; a < 2; ++a)
#pragma unroll
        for (int b = 0; b < 2; ++b)
#pragma unroll
            for (int m = 0; m < 4; ++m)
#pragma unroll
                for (int n = 0; n < 2; ++n) acc[a][b][m][n] = (f32x4){0.f, 0.f, 0.f, 0.f};
    bf16x8 At[4][2], B0[2][2], B1[2][2];
    const char* cA = (const char*)g.A + (size_t)cur.pm * tstep; const char* cB = (const char*)g.Bt + (size_t)cur.pn * tstep;
    S.a_ready(cur);
    if constexpr (SP2) {
        PG8_STAGE(PG8_SB(0, 0), cB, voffB); PG8_STAGE(PG8_SB(0, 1), cB + hstep, voffB); PG8_STAGE(PG8_SA(0, 0), cA, voffA); PG8_STAGE(PG8_SA(0, 1), cA + hstep, voffA);
        if (wr == 1) PG8_BAR;
        PG8_WAIT_V(2); PG8_BAR;
        PG8_STAGE(PG8_SB(1, 0), cB + kstep, voffB); PG8_STAGE(PG8_SA(1, 0), cA + kstep, voffA); PG8_STAGE(PG8_SB(1, 1), cB + hstep + kstep, voffB);
        PG8_WAIT_V(6); PG8_BAR;
    } else {
        PG8_STAGE(PG8_SB(0, 0), cB, voffB); PG8_STAGE(PG8_SA(0, 0), cA, voffA); PG8_STAGE(PG8_SB(0, 1), cB + hstep, voffB); PG8_STAGE(PG8_SA(0, 1), cA + hstep, voffA);
        if (wr == 1) PG8_BAR;
        PG8_WAIT_V(4); PG8_BAR;
        PG8_STAGE(PG8_SB(1, 0), cB + kstep, voffB); PG8_STAGE(PG8_SA(1, 0), cA + kstep, voffA); PG8_STAGE(PG8_SB(1, 1), cB + hstep + kstep, voffB);
        PG8_WAIT_V(6); PG8_BAR;
    }
    for (;;) {
        const bool has_next = S.next(ui + 1, nxt);
        const char* nA = has_next ? (const char*)g.A + (size_t)nxt.pm * tstep : cA; const char* nB = has_next ? (const char*)g.Bt + (size_t)nxt.pn * tstep : cB;
        for (int t = 0; t < nt; t += 2) {
            const bool last = (t == nt - 2);
            const char* a1 = cA + (size_t)(t + 1) * kstep;
            const char* a2 = last ? nA : cA + (size_t)(t + 2) * kstep; const char* b2 = last ? nB : cB + (size_t)(t + 2) * kstep;
            const char* a3 = a2 + kstep; const char* b3 = b2 + kstep;
            if (last && has_next) S.a_ready(nxt);
            if constexpr (SP2) {
            PG8_LDB(B0, 0, 0); PG8_LDB(B1, 0, 1); PG8_SCHED; PG8_LDA(At, 0, 0); PG8_STAGE(PG8_SA(1, 1), a1 + hstep, voffA);
            PG8_WAIT_V(8); PG8_WAIT_L(0); PG8_BAR; PG8_MMA(0, 0, At, B0); PG8_MMA(0, 1, At, B1); PG8_BAR; PG8_SCHED;
            PG8_LDA(At, 0, 1); PG8_STAGE(PG8_SB(0, 0), b2, voffB); PG8_STAGE(PG8_SB(0, 1), b2 + hstep, voffB); PG8_STAGE(PG8_SA(0, 0), a2, voffA);
            PG8_WAIT_V(8); PG8_WAIT_L(0); PG8_BAR; PG8_MMA(1, 0, At, B0); PG8_MMA(1, 1, At, B1); PG8_BAR; PG8_SCHED;
            PG8_LDB(B0, 1, 0); PG8_LDB(B1, 1, 1); PG8_SCHED; PG8_LDA(At, 1, 0); PG8_STAGE(PG8_SA(0, 1), a2 + hstep, voffA);
            PG8_WAIT_V(8); PG8_WAIT_L(0); PG8_BAR; PG8_MMA(0, 0, At, B0); PG8_MMA(0, 1, At, B1); PG8_BAR; PG8_SCHED;
            PG8_LDA(At, 1, 1); PG8_STAGE(PG8_SB(1, 0), b3, voffB); PG8_STAGE(PG8_SB(1, 1), b3 + hstep, voffB); PG8_STAGE(PG8_SA(1, 0), a3, voffA);
            PG8_WAIT_V(8); PG8_WAIT_L(0); PG8_BAR; PG8_MMA(1, 0, At, B0); PG8_MMA(1, 1, At, B1); PG8_BAR; PG8_SCHED;
            } else {
            PG8_LDB(B0, 0, 0); PG8_SCHED; PG8_LDA(At, 0, 0); PG8_STAGE(PG8_SA(1, 1), a1 + hstep, voffA);
            PG8_WAIT_L(8); PG8_BAR; PG8_WAIT_L(0); PG8_MMA(0, 0, At, B0); PG8_BAR; PG8_SCHED;
            PG8_LDB(B1, 0, 1); PG8_STAGE(PG8_SB(0, 0), b2, voffB);
            PG8_BAR; PG8_WAIT_L(0); PG8_MMA(0, 1, At, B1); PG8_BAR;
            PG8_LDA(At, 0, 1); PG8_STAGE(PG8_SA(0, 0), a2, voffA);
            PG8_BAR; PG8_WAIT_L(0); PG8_MMA(1, 0, At, B0); PG8_BAR; PG8_SCHED;
            PG8_STAGE(PG8_SB(0, 1), b2 + hstep, voffB);
            PG8_WAIT_V(6); PG8_BAR; PG8_MMA(1, 1, At, B1); PG8_BAR;
            PG8_LDB(B0, 1, 0); PG8_SCHED; PG8_LDA(At, 1, 0); PG8_STAGE(PG8_SA(0, 1), a2 + hstep, voffA);
            PG8_WAIT_L(8); PG8_BAR; PG8_WAIT_L(0); PG8_MMA(0, 0, At, B0); PG8_BAR; PG8_SCHED;
            PG8_LDB(B1, 1, 1); PG8_STAGE(PG8_SB(1, 0), b3, voffB);
            PG8_BAR; PG8_WAIT_L(0); PG8_MMA(0, 1, At, B1); PG8_BAR;
            PG8_LDA(At, 1, 1); PG8_STAGE(PG8_SA(1, 0), a3, voffA);
            PG8_BAR; PG8_WAIT_L(0); PG8_MMA(1, 0, At, B0); PG8_BAR; PG8_SCHED;
            PG8_STAGE(PG8_SB(1, 1), b3 + hstep, voffB);
            PG8_WAIT_V(6); PG8_BAR; PG8_MMA(1, 1, At, B1); PG8_BAR;
            }
        }
        if constexpr (ALIGN_EPI) { if (wr == 0) PG8_BAR; }
        if constexpr (!Epi::AFTER_DRAIN) { E(acc, cur, wr, wc, fr, fq); S.done(cur); }
        if (!has_next) break;
#pragma unroll
        for (int a = 0; a < 2; ++a)
#pragma unroll
            for (int b = 0; b < 2; ++b)
#pragma unroll
                for (int m = 0; m < 4; ++m)
#pragma unroll
                    for (int n = 0; n < 2; ++n) acc[a][b][m][n] = (f32x4){0.f, 0.f, 0.f, 0.f};
        cur = nxt; cA = nA; cB = nB; ++ui;
        if constexpr (ALIGN_EPI) { if (wr == 1) PG8_BAR; }
    }
    PG8_WAIT_V(0);
    if constexpr (!ALIGN_EPI) { if (wr == 0) PG8_BAR; }
    PG8_BAR;
    if constexpr (Epi::AFTER_DRAIN) { E.fused(acc, cur, wr, wc, fr, fq, lds, wid, lane); S.done(cur); }
#undef PG8_SA
#undef PG8_SB
#undef PG8_STAGE
#undef PG8_LDA
#undef PG8_LDB
#undef PG8_MMA
#undef PG8_WAIT_V
#undef PG8_WAIT_L
#undef PG8_BAR
#undef PG8_SCHED
}
}
template <bool PAIR, class RSF, class EPI>
__device__ __forceinline__ void ngemm(const bf16_t* A, int lda, const float* W, int ldw, const float* gk, int M, int N, int K, int pair_off,
                                      RSF rsf, EPI epi, const Ctx& c) {
    const int r = c.lane & 31, h = c.lane >> 5;
    const int ntn = N / 32, ntm = M / 64;
    for (int it = c.gw; it < ntm * ntn; it += c.ngw) {
        const int tn = it % ntn, tm = it / ntn;
        f32x16 a00 = {}, a10 = {}, a01 = {}, a11 = {};
        const bf16_t* a0 = A + (size_t)(tm * 64 + r) * lda + 8 * h;
        const bf16_t* a1 = a0 + (size_t)32 * lda;
        const float* w0 = W + (size_t)(8 * h) * ldw + tn * 32 + r;
        for (int k = 0; k < K; k += 16) {
            const bf16x8 fa0 = *(const bf16x8*)(a0 + k), fa1 = *(const bf16x8*)(a1 + k);
            bf16x8 fb, fb2;
#pragma unroll
            for (int j = 0; j < 8; ++j) {
                const float g = gk ? gk[k + 8 * h + j] : 1.0f;
                fb[j] = (short)f2bf(w0[(size_t)(k + j) * ldw] * g);
                if (PAIR) fb2[j] = (short)f2bf(w0[(size_t)(k + j) * ldw + pair_off] * g);
            }
            a00 = __builtin_amdgcn_mfma_f32_32x32x16_bf16(fa0, fb, a00, 0, 0, 0);
            a10 = __builtin_amdgcn_mfma_f32_32x32x16_bf16(fa1, fb, a10, 0, 0, 0);
            if (PAIR) {
                a01 = __builtin_amdgcn_mfma_f32_32x32x16_bf16(fa0, fb2, a01, 0, 0, 0);
                a11 = __builtin_amdgcn_mfma_f32_32x32x16_bf16(fa1, fb2, a11, 0, 0, 0);
            }
        }
        const int col = tn * 32 + r;
#pragma unroll
        for (int i = 0; i < 16; ++i) {
            const int row0 = tm * 64 + crow(i, h), row1 = row0 + 32;
            const float s0 = rsf(row0), s1 = rsf(row1);
            epi(row0, col, a00[i] * s0, a01[i] * s0);
            epi(row1, col, a10[i] * s1, a11[i] * s1);
        }
    }
}

__device__ __forceinline__ void nrow_prep(const float* x, bf16_t* xb, float* rs, int nrows, const Ctx& c) {
    for (int row = c.gw; row < nrows; row += c.ngw) {
        const f32x4* xr = (const f32x4*)(x + (size_t)row * DM) + c.lane;
        f32x4 v[4]; float ss = 0.f;
#pragma unroll
        for (int j = 0; j < 4; ++j) { v[j] = xr[64 * j]; ss += (v[j].x * v[j].x + v[j].y * v[j].y) + (v[j].z * v[j].z + v[j].w * v[j].w); }
        ss = wave_sum(ss);
        u32x2* o = (u32x2*)(xb + (size_t)row * DM) + c.lane;
#pragma unroll
        for (int j = 0; j < 4; ++j) { u32x2 w; w.x = pk2(v[j].x, v[j].y); w.y = pk2(v[j].z, v[j].w); o[64 * j] = w; }
        if (c.lane == 0) rs[row] = rsqrtf(ss * (1.0f / DM) + EPS);
    }
}
__device__ __forceinline__ void nrow_memn(const float* mem, const float* g, bf16_t* memn, const Ctx& c) {
    for (int row = c.gw; row < MT; row += c.ngw) {
        const f32x4* xr = (const f32x4*)(mem + (size_t)row * DM) + c.lane; const f32x4* gr = (const f32x4*)g + c.lane;
        f32x4 v[4]; float ss = 0.f;
#pragma unroll
        for (int j = 0; j < 4; ++j) { v[j] = xr[64 * j]; ss += (v[j].x * v[j].x + v[j].y * v[j].y) + (v[j].z * v[j].z + v[j].w * v[j].w); }
        const float rs = rsqrtf(wave_sum(ss) * (1.0f / DM) + EPS);
        u32x2* o = (u32x2*)(memn + (size_t)row * DM) + c.lane;
#pragma unroll
        for (int j = 0; j < 4; ++j) { const f32x4 gg = gr[64 * j]; u32x2 w; w.x = pk2(v[j].x * rs * gg.x, v[j].y * rs * gg.y); w.y = pk2(v[j].z * rs * gg.z, v[j].w * rs * gg.w); o[64 * j] = w; }
    }
}
__device__ __forceinline__ void nrope_tables(const int* pos, float* cosT, float* sinT, const Ctx& c) {
    for (int i = c.gt; i < T * 32; i += c.ngt) {
        const int row = i >> 5, k = i & 31;
        const float inv = (float)exp2(-(double)k * (13.287712379549449 / 32.0));
        const float ang = (float)pos[row] * inv;
        const double a = (double)ang; const double n = rint(a * 0.15915494309189535);
        const float rr = (float)((a - n * 6.283185307179586) - n * 2.4492935982947064e-16);
        cosT[i] = cosf(rr); sinT[i] = sinf(rr);
    }
}
__device__ __forceinline__ void nrow_resnorm(const float* base, const float* y, const float* g, float coef, float* xout, bf16_t* xb, float* rs_out, const Ctx& c) {
    for (int row = c.gw; row < T; row += c.ngw) {
        const f32x4* yr = (const f32x4*)(y + (size_t)row * DM) + c.lane; const f32x4* br = (const f32x4*)(base + (size_t)row * DM) + c.lane; const f32x4* gr = (const f32x4*)g + c.lane;
        f32x4 v[4]; float ss = 0.f;
#pragma unroll
        for (int j = 0; j < 4; ++j) { v[j] = yr[64 * j]; ss += (v[j].x * v[j].x + v[j].y * v[j].y) + (v[j].z * v[j].z + v[j].w * v[j].w); }
        const float rs = rsqrtf(wave_sum(ss) * (1.0f / DM) + EPS) * coef;
        float s2 = 0.f;
#pragma unroll
        for (int j = 0; j < 4; ++j) { const f32x4 gg = gr[64 * j], bb = br[64 * j]; v[j] = bb + v[j] * rs * gg; s2 += (v[j].x * v[j].x + v[j].y * v[j].y) + (v[j].z * v[j].z + v[j].w * v[j].w); }
        s2 = wave_sum(s2);
        f32x4* xo = (f32x4*)(xout + (size_t)row * DM) + c.lane; u32x2* o = (u32x2*)(xb + (size_t)row * DM) + c.lane;
#pragma unroll
        for (int j = 0; j < 4; ++j) { xo[64 * j] = v[j]; u32x2 w; w.x = pk2(v[j].x, v[j].y); w.y = pk2(v[j].z, v[j].w); o[64 * j] = w; }
        if (c.lane == 0) rs_out[row] = rsqrtf(s2 * (1.0f / DM) + EPS);
    }
}
__device__ __forceinline__ void nrow_ssq(const bf16_t* cq, const bf16_t* ckv, float* ssq_q, float* ssq_kv, const Ctx& c) {
    for (int row = c.gw; row < T; row += c.ngw) {
        float s = 0.f;
        for (int d = c.lane; d < QLR; d += 64) { const float v = bf2f(cq[(size_t)row * QLR + d]); s += v * v; }
        s = wave_sum(s);
        float s2 = 0.f;
        for (int d = c.lane; d < KVLR; d += 64) { const float v = bf2f(ckv[(size_t)row * KVLR + d]); s2 += v * v; }
        s2 = wave_sum(s2);
        if (c.lane < 12) ssq_q[(size_t)row * 12 + c.lane] = c.lane == 0 ? s : 0.f;
        if (c.lane < 8) ssq_kv[(size_t)row * 8 + c.lane] = c.lane == 0 ? s2 : 0.f;
    }
}
__device__ __forceinline__ void nrope_apply(bf16_t* Q, const bf16_t* kper, bf16_t* kpe, const float* cosT, const float* sinT, const Ctx& c) {
    for (int i = c.gt; i < T * 5 * 32; i += c.ngt) {
        const int k = i & 31, hh = (i >> 5) % 5, row = i / 160;
        const float cs = cosT[row * 32 + k], sn = sinT[row * 32 + k];
        if (hh < 4) { bf16_t* q = Q + (size_t)row * 768 + hh * DQK + DN; const float x1 = bf2f(q[k]), x2 = bf2f(q[k + 32]);
            q[k] = (bf16_t)f2bf(x1 * cs - x2 * sn); q[k + 32] = (bf16_t)f2bf(x2 * cs + x1 * sn); }
        else { const bf16_t* s = kper + (size_t)row * 64; const float x1 = bf2f(s[k]), x2 = bf2f(s[k + 32]);
            bf16_t* o = kpe + (size_t)row * 64; o[k] = (bf16_t)f2bf(x1 * cs - x2 * sn); o[k + 32] = (bf16_t)f2bf(x2 * cs + x1 * sn); }
    }
}

struct AttnDesc { const bf16_t* Q; int ldq, qhs; const bf16_t* K; int ldk, khs; const bf16_t* Kpe; const bf16_t* V; int ldv, vhs; bf16_t* O; int ldo, ohs; int SQ, SK; float scale; };
template <bool CAUSAL, bool PE>
__device__ __forceinline__ void nattn(const AttnDesc& d, const Ctx& c, float* wl  ) {
    constexpr int DQ = PE ? DQK : DN;
    const int nitems = BATCH * NH * d.SQ;
    float* qs = wl; float* pw = wl + 192;
    for (int it = c.gw; it < nitems; it += c.ngw) {
        const int i = it % d.SQ, bh = it / d.SQ, h = bh % NH, b = bh / NH;
        const bf16_t* qrow = d.Q + (size_t)(b * d.SQ + i) * d.ldq + h * d.qhs;
        asm volatile("s_waitcnt lgkmcnt(0)" ::: "memory");
        for (int dd = c.lane; dd < DQ; dd += 64) qs[dd] = bf2f(qrow[dd]) * d.scale;
        asm volatile("s_waitcnt lgkmcnt(0)" ::: "memory");
        const int nk = CAUSAL ? i + 1 : d.SK;
        float m = -1e30f, l = 0.f, o0 = 0.f, o1 = 0.f;
        for (int t0 = 0; t0 < nk; t0 += 64) {
            const int j = t0 + c.lane; const bool valid = j < nk; const int jj = valid ? j : nk - 1;
            const bf16_t* kr = d.K + (size_t)(b * d.SK + jj) * d.ldk + h * d.khs;
            float s = 0.f;
#pragma unroll 4
            for (int cc = 0; cc < 16; ++cc) { const bf16x8 kv = *(const bf16x8*)(kr + cc * 8); const f32x4 q0 = *(const f32x4*)(qs + cc * 8), q1 = *(const f32x4*)(qs + cc * 8 + 4);
                s += bfs(kv[0]) * q0.x + bfs(kv[1]) * q0.y + bfs(kv[2]) * q0.z + bfs(kv[3]) * q0.w + bfs(kv[4]) * q1.x + bfs(kv[5]) * q1.y + bfs(kv[6]) * q1.z + bfs(kv[7]) * q1.w; }
            if (PE) { const bf16_t* kp = d.Kpe + (size_t)(b * d.SK + jj) * DR;
#pragma unroll 4
                for (int cc = 0; cc < 8; ++cc) { const bf16x8 kv = *(const bf16x8*)(kp + cc * 8); const f32x4 q0 = *(const f32x4*)(qs + DN + cc * 8), q1 = *(const f32x4*)(qs + DN + cc * 8 + 4);
                    s += bfs(kv[0]) * q0.x + bfs(kv[1]) * q0.y + bfs(kv[2]) * q0.z + bfs(kv[3]) * q0.w + bfs(kv[4]) * q1.x + bfs(kv[5]) * q1.y + bfs(kv[6]) * q1.z + bfs(kv[7]) * q1.w; } }
            if (!valid) s = -__builtin_inff();
            const float mn = fmaxf(m, wave_max(s));
            const float alpha = __expf(m - mn);
            const float pj = valid ? __expf(s - mn) : 0.f;
            l = l * alpha + wave_sum(pj); o0 *= alpha; o1 *= alpha; m = mn;
            asm volatile("s_waitcnt lgkmcnt(0)" ::: "memory");
            pw[c.lane] = pj;
            asm volatile("s_waitcnt lgkmcnt(0)" ::: "memory");
            const int cnt = (nk - t0) < 64 ? (nk - t0) : 64;
            const bf16_t* vr = d.V + (size_t)(b * d.SK + t0) * d.ldv + h * d.vhs + c.lane;
            for (int e = 0; e < cnt; ++e) { const float pe = pw[e]; o0 += pe * bf2f(vr[(size_t)e * d.ldv]); o1 += pe * bf2f(vr[(size_t)e * d.ldv + 64]); }
        }
        const float il = 1.0f / l;
        bf16_t* orow = d.O + (size_t)(b * d.SQ + i) * d.ldo + h * d.ohs;
        orow[c.lane] = (bf16_t)f2bf(o0 * il); orow[c.lane + 64] = (bf16_t)f2bf(o1 * il);
    }
}

__device__ __forceinline__ void nlru(const bf16_t* U, const bf16_t* G, const float* conv_w, const float* conv_b, const float* w_a, const float* b_a,
                                     const float* w_x, const float* b_x, const float* lam, bf16_t* ycat, int item, int lane) {
    const int b = item / NBLK, n = item % NBLK, ch = n * BD + lane;
    float wa[64], wx[64];
#pragma unroll
    for (int dd = 0; dd < 64; ++dd) { wa[dd] = w_a[(size_t)(n * 64 + dd) * 64 + lane]; wx[dd] = w_x[(size_t)(n * 64 + dd) * 64 + lane]; }
    const float cw0 = conv_w[ch], cw1 = conv_w[LRUW + ch], cw2 = conv_w[2 * LRUW + ch], cw3 = conv_w[3 * LRUW + ch], cb = conv_b[ch];
    const float ba = b_a[n * 64 + lane], bx = b_x[n * 64 + lane];
    const float sp = log1pf(expf(-lam[ch]));
    float u3 = 0.f, u2 = 0.f, u1 = 0.f, hst = 0.f;
    for (int t = 0; t < SEQ; ++t) {
        const size_t row = (size_t)b * SEQ + t;
        const float u0 = bf2f(U[row * LRUW + ch]);
        const float xc = cb + cw0 * u3 + cw1 * u2 + cw2 * u1 + cw3 * u0;
        float ra = ba, ri = bx;
#pragma unroll
        for (int dd = 0; dd < 64; ++dd) { const float xd = __shfl(xc, dd); ra += xd * wa[dd]; ri += xd * wx[dd]; }
        const float rg = sigmoidf_(ra), ig = sigmoidf_(ri);
        const float log_a = -8.0f * rg * sp;
        const float a = expf(log_a);
        const float bb = sqrtf(-expm1f(2.0f * log_a)) * (ig * xc);
        hst = a * hst + bb;
        const float gt = bf2f(G[row * LRUW + ch]);
        ycat[row * DM + LRUW + ch] = (bf16_t)f2bf(hst * gelu_tanh(gt));
        u3 = u2; u2 = u1; u1 = u0;
    }
}


constexpr int LCH = 128, NCHUNK = SEQ / LCH;
__device__ __forceinline__ void lru_a(const bf16_t* U, const float* conv_w, const float* conv_b, const float* w_a, const float* b_a, const float* w_x, const float* b_x,
                                      const float* lam, bf16_t* HL, bf16_t* PC, float* sumA, float* sumB, int item, float* wl, int n, int lane) {
    asm volatile("" : "+v"(lane));
    const int b = item / NCHUNK, cidx = item % NCHUNK, ch = n * BD + lane;
    float wa[64], wx[64];
#pragma unroll
    for (int dd = 0; dd < 64; ++dd) { wa[dd] = w_a[(size_t)(n * 64 + dd) * 64 + lane]; wx[dd] = w_x[(size_t)(n * 64 + dd) * 64 + lane]; }
    const float cw0 = conv_w[ch], cw1 = conv_w[LRUW + ch], cw2 = conv_w[2 * LRUW + ch], cw3 = conv_w[3 * LRUW + ch], cb = conv_b[ch];
    const float ba = b_a[n * 64 + lane], bx = b_x[n * 64 + lane];
    const float sp8 = -8.0f * log1pf(expf(-lam[ch]));
    const size_t row0 = (size_t)b * SEQ + (size_t)cidx * LCH;
    const bf16_t* up = U + row0 * LRUW + ch;
    float u3 = 0.f, u2 = 0.f, u1 = 0.f;
    if (cidx > 0) { u3 = bf2f(up[-3 * LRUW]); u2 = bf2f(up[-2 * LRUW]); u1 = bf2f(up[-1 * LRUW]); }
    float hst = 0.f, pst = 1.f;
    float q0, q1, q2, q3, q4, q5, q6, q7;
    q0 = bf2f(up[0]); q1 = bf2f(up[(size_t)1 * LRUW]); q2 = bf2f(up[(size_t)2 * LRUW]); q3 = bf2f(up[(size_t)3 * LRUW]);
    q4 = bf2f(up[(size_t)4 * LRUW]); q5 = bf2f(up[(size_t)5 * LRUW]); q6 = bf2f(up[(size_t)6 * LRUW]); q7 = bf2f(up[(size_t)7 * LRUW]);
#pragma unroll 1
    for (int tt = 0; tt < LCH; ++tt) {
        const float u0 = q0;
        q0 = q1; q1 = q2; q2 = q3; q3 = q4; q4 = q5; q5 = q6; q6 = q7;
        { const int tn = tt + 8 < LCH ? tt + 8 : LCH - 1; q7 = bf2f(up[(size_t)tn * LRUW]); }
        const float xc = cb + cw0 * u3 + cw1 * u2 + cw2 * u1 + cw3 * u0;
        float* xs = wl + (tt & 1) * 64;
        xs[lane] = xc;
        asm volatile("s_waitcnt lgkmcnt(0)" ::: "memory");
        float ra = ba, ri = bx;
#pragma unroll
        for (int q = 0; q < 16; ++q) { const f32x4 x4 = *(const f32x4*)(xs + 4 * q);
            ra += x4.x * wa[4 * q] + x4.y * wa[4 * q + 1] + x4.z * wa[4 * q + 2] + x4.w * wa[4 * q + 3];
            ri += x4.x * wx[4 * q] + x4.y * wx[4 * q + 1] + x4.z * wx[4 * q + 2] + x4.w * wx[4 * q + 3]; }
        const float rg = sigmoidf_(ra), ig = sigmoidf_(ri);
        const float log_a = sp8 * rg;
        const float a = __expf(log_a);
        const float bb = sqrtf(-expm1f(2.0f * log_a)) * (ig * xc);
        hst = a * hst + bb; pst = pst * a;
        const size_t off = (row0 + (size_t)tt) * LRUW + ch;
        HL[off] = (bf16_t)f2bf(hst); PC[off] = (bf16_t)f2bf(pst);
        u3 = u2; u2 = u1; u1 = u0;
    }
    sumA[(size_t)item * LRUW + ch] = pst; sumB[(size_t)item * LRUW + ch] = hst;
}
__device__ __forceinline__ void lru_c(const bf16_t* HL, const bf16_t* PC, const bf16_t* G, const float* sumA, const float* sumB, bf16_t* ycat, int item, float* cl  , int tid) {
    const int b = item / NCHUNK, cidx = item % NCHUNK;
    { float carry = 0.f; const float* sa = sumA + (size_t)b * NCHUNK * LRUW + tid; const float* sb = sumB + (size_t)b * NCHUNK * LRUW + tid;
#pragma unroll 8
      for (int c2 = 0; c2 < cidx; ++c2) carry = sa[(size_t)c2 * LRUW] * carry + sb[(size_t)c2 * LRUW];
      cl[tid] = carry; }
    __syncthreads();
    const int c8 = (tid & 63) * 8, r0 = tid >> 6;
    const f32x4 ca = *(const f32x4*)(cl + c8), cb = *(const f32x4*)(cl + c8 + 4);
    const float cr[8] = {ca.x, ca.y, ca.z, ca.w, cb.x, cb.y, cb.z, cb.w};
    const size_t row0 = (size_t)b * SEQ + (size_t)cidx * LCH;
#pragma unroll 4
    for (int r = r0; r < LCH; r += 8) {
        const size_t off = (row0 + r) * LRUW + c8;
        const bf16x8 h8 = *(const bf16x8*)(HL + off), p8 = *(const bf16x8*)(PC + off), g8 = *(const bf16x8*)(G + off);
        float y[8];
#pragma unroll
        for (int e = 0; e < 8; ++e) y[e] = (bfs(h8[e]) + bfs(p8[e]) * cr[e]) * gelu_tanh(bfs(g8[e]));
        u32x4 w; w.x = pk2(y[0], y[1]); w.y = pk2(y[2], y[3]); w.z = pk2(y[4], y[5]); w.w = pk2(y[6], y[7]);
        *(u32x4*)(ycat + (row0 + r) * DM + LRUW + c8) = w;
    }
    __syncthreads();
}

namespace att {
typedef short s16x4 __attribute__((ext_vector_type(4)));
constexpr int NW = 8, QBLK = 32, KVBLK = 64, QB = NW * QBLK, D = 128;
constexpr int SHM_V = KVBLK * D * 2, SHM_KN = KVBLK * D * 2, SHM_KP = KVBLK * 64 * 2, SHM_K = SHM_KN + SHM_KP;
constexpr float THR = 8.f;
#define KSWZ(row, colB) ((row) * 256 + ((colB) ^ (((row) & 7) << 4)))
#define SBAR() __builtin_amdgcn_sched_barrier(0)
__device__ __forceinline__ int v_st(int k, int c) { const int kk = (k & ~0xC) | ((k & 4) << 1) | ((k & 8) >> 1); return ((kk >> 3) * 4 + (c >> 5)) * 512 + ((kk & 7) * 32 + (c & 31)) * 2; }
__device__ __forceinline__ int v_rd_base(int lane) { return ((lane & 3) << 3) | (((lane >> 2) & 3) << 6) | (((lane >> 4) & 1) << 5) | (((lane >> 5) & 1) << 8); }
constexpr int v_rd_off(int d0, int ks, int half) { return d0 * 512 + ks * 4096 + half * 2048; }
__device__ __forceinline__ unsigned cvtpk(float lo, float hi) { unsigned r; asm volatile("v_cvt_pk_bf16_f32 %0, %1, %2" : "=v"(r) : "v"(lo), "v"(hi)); return r; }
__device__ __forceinline__ bf16x8 load8(const bf16_t* p) { return *reinterpret_cast<const bf16x8*>(p); }
__device__ __forceinline__ void mask_tile(f32x16& p0, f32x16& p1, int dq, unsigned W) {
    const float NEG = -__builtin_inff();
#pragma unroll
    for (int r = 0; r < 16; ++r) {
        const int c = (r & 3) + 8 * (r >> 2);
        if ((unsigned)(dq - c) >= W) p0[r] = NEG;
        if ((unsigned)(dq - c - 32) >= W) p1[r] = NEG;
    }
}
template <bool PE> __device__ __forceinline__ void partialSM(f32x16& p0, f32x16& p1, float& m_reg, float& mn, float& alpha) {
    constexpr float SCALE = PE ? 0.07216878364870322f : 0.08838834764831845f;
    float pmax = p0[0]; for (int r = 1; r < 16; ++r) pmax = fmaxf(pmax, p0[r]); for (int r = 0; r < 16; ++r) pmax = fmaxf(pmax, p1[r]);
    { auto rr = __builtin_amdgcn_permlane32_swap(__float_as_uint(pmax), __float_as_uint(pmax), false, false);
      pmax = fmaxf(__uint_as_float(rr[0]), __uint_as_float(rr[1])); }
    constexpr float C2 = 1.4426950408889634f * SCALE;
    if (__builtin_expect(__all((pmax - m_reg) * SCALE <= THR), 1)) { mn = m_reg; alpha = 1.f; }
    else { mn = fmaxf(m_reg, pmax); alpha = __builtin_amdgcn_exp2f((m_reg - mn) * C2); m_reg = mn; }
    const float mnL = -mn * C2;
    for (int r = 0; r < 16; ++r) p0[r] = fmaf(p0[r], C2, mnL); for (int r = 0; r < 16; ++r) p1[r] = fmaf(p1[r], C2, mnL);
    for (int r = 0; r < 16; ++r) p0[r] = __builtin_amdgcn_exp2f(p0[r]);
}
__device__ __forceinline__ void finishSM(f32x16& p0, f32x16& p1, float alpha, float& l_reg, bf16x8& pa0, bf16x8& pa1, bf16x8& pa2, bf16x8& pa3) {
    for (int r = 0; r < 16; ++r) p1[r] = __builtin_amdgcn_exp2f(p1[r]);
    float ps = 0; for (int r = 0; r < 16; ++r) ps += p0[r]; for (int r = 0; r < 16; ++r) ps += p1[r];
    { auto rr = __builtin_amdgcn_permlane32_swap(__float_as_uint(ps), __float_as_uint(ps), false, false);
      ps = __uint_as_float(rr[0]) + __uint_as_float(rr[1]); }
    l_reg = l_reg * alpha + ps;
#define PK4(P, B_, OUT) do { unsigned a0 = cvtpk(P[B_+0], P[B_+1]), a1 = cvtpk(P[B_+2], P[B_+3]);                          \
        unsigned b0 = cvtpk(P[B_+4], P[B_+5]), b1 = cvtpk(P[B_+6], P[B_+7]);                                             \
        auto r0 = __builtin_amdgcn_permlane32_swap(a0, b0, false, false); auto r1 = __builtin_amdgcn_permlane32_swap(a1, b1, false, false); \
        u32x4 w = {r0[0], r1[0], r0[1], r1[1]}; OUT = *reinterpret_cast<bf16x8*>(&w); } while (0)
    PK4(p0, 0, pa0); PK4(p0, 8, pa1); PK4(p1, 0, pa2); PK4(p1, 8, pa3);
#undef PK4
}
template <int KB, bool PE>
__device__ __forceinline__ void qkt(f32x16& p0, f32x16& p1, const char* K_lds, int r32, int hi, const bf16x8* qr, const char* qpe_l) {
    p0 = f32x16{}; p1 = f32x16{};
    const char* kb[4];
#pragma unroll
    for (int dd = 0; dd < 4; ++dd) kb[dd] = K_lds + KB * SHM_K + KSWZ(r32, (dd * 16 + hi * 8) * 2);
#pragma unroll
    for (int d0 = 0; d0 < 8; ++d0) { const char* a = kb[d0 & 3] + (d0 >> 2) * 128;
        bf16x8 b0 = *reinterpret_cast<const bf16x8*>(a);
        bf16x8 b1 = *reinterpret_cast<const bf16x8*>(a + 32 * 256);
        p0 = __builtin_amdgcn_mfma_f32_32x32x16_bf16(b0, qr[d0], p0, 0, 0, 0);
        p1 = __builtin_amdgcn_mfma_f32_32x32x16_bf16(b1, qr[d0], p1, 0, 0, 0); }
    if (PE) {
#pragma unroll
        for (int d0 = 0; d0 < 4; ++d0) { const char* a = kb[d0] + SHM_KN;
            bf16x8 b0 = *reinterpret_cast<const bf16x8*>(a);
            bf16x8 b1 = *reinterpret_cast<const bf16x8*>(a + 128);
            const bf16x8 qf = *reinterpret_cast<const bf16x8*>(qpe_l + d0 * 32);
            p0 = __builtin_amdgcn_mfma_f32_32x32x16_bf16(b0, qf, p0, 0, 0, 0);
            p1 = __builtin_amdgcn_mfma_f32_32x32x16_bf16(b1, qf, p1, 0, 0, 0); }
    }
}
__device__ __forceinline__ void pv_tile(f32x16* o, int vb0, bf16x8 pa0, bf16x8 pa1, bf16x8 pa2, bf16x8 pa3) {
#define TRRD(dst, off) asm volatile("ds_read_b64_tr_b16 %0, %1 offset:%2" : "=&v"(dst) : "v"(vb0), "i"(off) : "memory")
#define PV_D0(d0) do { s16x4 l0, l1, l2, l3, h0, h1, h2, h3; constexpr int b_ = v_rd_off(d0, 0, 0);   \
        TRRD(l0, b_); TRRD(h0, b_ + 2048); TRRD(l1, b_ + 4096); TRRD(h1, b_ + 6144); TRRD(l2, b_ + 8192); TRRD(h2, b_ + 10240); TRRD(l3, b_ + 12288); TRRD(h3, b_ + 14336); \
        asm volatile("s_waitcnt lgkmcnt(0)" ::: "memory"); SBAR();   \
        o[d0] = __builtin_amdgcn_mfma_f32_32x32x16_bf16(pa0, (bf16x8){l0[0], l0[1], l0[2], l0[3], h0[0], h0[1], h0[2], h0[3]}, o[d0], 0, 0, 0);   \
        o[d0] = __builtin_amdgcn_mfma_f32_32x32x16_bf16(pa1, (bf16x8){l1[0], l1[1], l1[2], l1[3], h1[0], h1[1], h1[2], h1[3]}, o[d0], 0, 0, 0);   \
        o[d0] = __builtin_amdgcn_mfma_f32_32x32x16_bf16(pa2, (bf16x8){l2[0], l2[1], l2[2], l2[3], h2[0], h2[1], h2[2], h2[3]}, o[d0], 0, 0, 0);   \
        o[d0] = __builtin_amdgcn_mfma_f32_32x32x16_bf16(pa3, (bf16x8){l3[0], l3[1], l3[2], l3[3], h3[0], h3[1], h3[2], h3[3]}, o[d0], 0, 0, 0); } while (0)
    PV_D0(0); PV_D0(1); PV_D0(2); PV_D0(3);
#undef PV_D0
#undef TRRD
}

struct BlockRef { const bf16_t* Q; const bf16_t* K; const bf16_t* Kp; const bf16_t* V; bf16_t* O; int P0; };
template <bool PE> struct Seam { bf16x8 qr[8]; bf16x8 qpe[4]; };
__device__ __forceinline__ int swa_jlo(int P0, int W) { const int lowk = P0 - W + 1; return lowk > 0 ? lowk / KVBLK : 0; }
constexpr int LDS_V = 0, LDS_K = 3 * SHM_V, LDS_QPE = LDS_K + 2 * SHM_K, QPE_WAVE = 32 * 144, LDS_WS = LDS_QPE + NW * QPE_WAVE, ATT_LDS_TOTAL = LDS_WS + NW * 64 * 4;
typedef __attribute__((address_space(3))) unsigned lds_u32;
#define VMW() asm volatile("s_waitcnt vmcnt(0)" ::: "memory")
#define DMA_TILE(Kp_, Pp_, Vp_, k0, kbuf, vbyte) do {                                                                                         \
        _Pragma("unroll") for (int i_ = 0; i_ < 2; ++i_) {                                                                                    \
            __builtin_amdgcn_global_load_lds((const unsigned*)((Kp_) + (size_t)(k0) * LDK + koff[i_]), (lds_u32*)(lds + LDS_K + (kbuf) * SHM_K + (wid + 8 * i_) * 1024), 16, 0, 0);   \
            __builtin_amdgcn_global_load_lds((const unsigned*)((Vp_) + (size_t)(k0) * LDV + voff[i_]), (lds_u32*)(lds + LDS_V + (vbyte) + (wid + 8 * i_) * 1024), 16, 0, 0); }       \
        if (PE) __builtin_amdgcn_global_load_lds((const unsigned*)((Pp_) + (size_t)(k0) * 64 + poff), (lds_u32*)(lds + LDS_K + (kbuf) * SHM_K + SHM_KN + wid * 1024), 16, 0, 0); } while (0)
#define DMA_OFFS()                                                                                                                            \
    int koff[2], voff[2], poff;                                                                                                               \
    _Pragma("unroll") for (int i_ = 0; i_ < 2; ++i_) { const int pc_ = wid + 8 * i_, row_ = pc_ * 4 + (lane >> 4), ch_ = (lane & 15) ^ (row_ & 7); koff[i_] = row_ * LDK + ch_ * 8;   \
        const int sub_ = pc_ * 2 + (lane >> 5), kk_ = (sub_ >> 2) * 8 + ((lane & 31) >> 2), k_ = (kk_ & ~0xC) | ((kk_ & 4) << 1) | ((kk_ & 8) >> 1); voff[i_] = k_ * LDV + (sub_ & 3) * 32 + (lane & 3) * 8; } \
    { const int row_ = wid * 4 + (lane >> 4), c16_ = (lane & 15) ^ (row_ & 7); poff = (row_ + 32 * (c16_ >> 3)) * 64 + (c16_ & 7) * 8; }

template <bool PE, int LDQ, int LDK, int LDV, int LDO>
__device__ __forceinline__ void attn_prime(const BlockRef& cur, int W, char* lds, Seam<PE>& S) {
    int tid_raw = threadIdx.x; asm volatile("" : "+v"(tid_raw));
    const int tid = tid_raw, wid = __builtin_amdgcn_readfirstlane(tid >> 6), lane = tid & 63, r32 = lane & 31, hi = lane >> 5;
    DMA_OFFS();
    const int kb0 = swa_jlo(cur.P0, W) * KVBLK;
    DMA_TILE(cur.K, cur.Kp, cur.V, kb0, 0, 0);
#pragma unroll
    for (int d0 = 0; d0 < 8; ++d0) S.qr[d0] = load8(cur.Q + (size_t)(wid * QBLK + r32) * LDQ + d0 * 16 + hi * 8);
    if (PE) {
#pragma unroll
        for (int d0 = 0; d0 < 4; ++d0) S.qpe[d0] = load8(cur.Q + (size_t)(wid * QBLK + r32) * LDQ + 128 + d0 * 16 + hi * 8); }
    VMW(); __syncthreads();
}
template <bool PE, int LDQ, int LDK, int LDV, int LDO>
__device__ __forceinline__ void attn_block(const BlockRef& cur, const BlockRef& nxt, int skv, int W, char* lds, Seam<PE>& S) {
    int tid_raw = threadIdx.x; asm volatile("" : "+v"(tid_raw));
    const int tid = tid_raw, wid = __builtin_amdgcn_readfirstlane(tid >> 6), lane = tid & 63, r32 = lane & 31, hi = lane >> 5;
    const int j_lo = swa_jlo(cur.P0, W);
    int j_hi = (cur.P0 + QB - 1) / KVBLK + 1; if (j_hi > skv / KVBLK) j_hi = skv / KVBLK;
    const int NT = j_hi - j_lo;
    const int kbn = swa_jlo(nxt.P0, W) * KVBLK;
    const int qlo = cur.P0 + wid * QBLK, qm = qlo + r32 - 4 * hi;
    char* K_lds = lds + LDS_K;
    float* ws = (float*)(lds + LDS_WS) + wid * 64; float* li_l = ws, * al_l = ws + 32;
    char* qpe_l = lds + LDS_QPE + wid * QPE_WAVE + r32 * 144 + hi * 16;
    float m_reg = -1e30f, l_reg = 0; f32x16 o[4] = {};
    DMA_OFFS();
    const int vb0 = (int)(uintptr_t)(lds + LDS_V) + v_rd_base(lane);
    const bf16_t* Kh = cur.K; const bf16_t* Ph = cur.Kp; const bf16_t* Vh = cur.V;
#define RESC(a) do { if (__any((a) < 1.f)) { if (hi == 0) al_l[r32] = (a); asm volatile("s_waitcnt lgkmcnt(0)" ::: "memory");              \
                     for (int d_ = 0; d_ < 4; ++d_) for (int r = 0; r < 16; ++r) o[d_][r] *= al_l[crow(r, hi)]; } } while (0)
#define KBASE(t) ((j_lo + (t)) * KVBLK)
#define MASKT(P0_, P1_, t) do { const int kb_ = KBASE(t); if (kb_ + KVBLK - 1 > qlo || kb_ <= qlo + QBLK - 1 - W) mask_tile(P0_, P1_, qm - kb_, (unsigned)W); } while (0)
#define ROT() do { const int t_ = vs_prev; vs_prev = vs_cur; vs_cur = vs_next; vs_next = t_; } while (0)
    f32x16 pA0, pA1, pB0, pB1; float mnA, mnB, alA, alB; bf16x8 pa0, pa1, pa2, pa3;
    int vs_prev = 2 * SHM_V, vs_cur = 0, vs_next = SHM_V;
    if (PE) {
#pragma unroll
        for (int d0 = 0; d0 < 4; ++d0) *(bf16x8*)(qpe_l + d0 * 32) = S.qpe[d0];
        asm volatile("s_waitcnt lgkmcnt(0)" ::: "memory"); }
    DMA_TILE(Kh, Ph, Vh, KBASE(1), 1, vs_next);
    SBAR(); qkt<0, PE>(pA0, pA1, K_lds, r32, hi, S.qr, qpe_l);
    MASKT(pA0, pA1, 0); partialSM<PE>(pA0, pA1, m_reg, mnA, alA);
    VMW(); __syncthreads(); ROT();
#define STEP(PX0, PX1, mnX, alX, PY0, PY1, alY, t, KB, DMA_ON) do {                                                           \
        if (DMA_ON) DMA_TILE(Kh, Ph, Vh, KBASE((t) + 1), (KB) ^ 1, vs_next);                                                  \
        SBAR(); qkt<KB, PE>(PX0, PX1, K_lds, r32, hi, S.qr, qpe_l);                                                           \
        finishSM(PY0, PY1, alY, l_reg, pa0, pa1, pa2, pa3); SBAR();                                                           \
        pv_tile(o, vb0 + vs_prev, pa0, pa1, pa2, pa3); MASKT(PX0, PX1, (t)); partialSM<PE>(PX0, PX1, m_reg, mnX, alX);        \
        RESC(alX); VMW(); __syncthreads(); ROT(); } while (0)
    for (int t = 1; t + 1 < NT; t += 2) {
        STEP(pB0, pB1, mnB, alB, pA0, pA1, alA, t, 1, true);
        STEP(pA0, pA1, mnA, alA, pB0, pB1, alB, t + 1, 0, true);
    }
    SBAR(); qkt<1, PE>(pB0, pB1, K_lds, r32, hi, S.qr, qpe_l); SBAR();
    finishSM(pA0, pA1, alA, l_reg, pa0, pa1, pa2, pa3); SBAR();
    pv_tile(o, vb0 + vs_prev, pa0, pa1, pa2, pa3);
    MASKT(pB0, pB1, NT - 1); partialSM<PE>(pB0, pB1, m_reg, mnB, alB); RESC(alB);
    finishSM(pB0, pB1, alB, l_reg, pa0, pa1, pa2, pa3); SBAR(); pv_tile(o, vb0 + vs_cur, pa0, pa1, pa2, pa3);
    __syncthreads();
    DMA_TILE(nxt.K, nxt.Kp, nxt.V, kbn, 0, 0);
#pragma unroll
    for (int d0 = 0; d0 < 8; ++d0) S.qr[d0] = load8(nxt.Q + (size_t)(wid * QBLK + r32) * LDQ + d0 * 16 + hi * 8);
    if (PE) {
#pragma unroll
        for (int d0 = 0; d0 < 4; ++d0) S.qpe[d0] = load8(nxt.Q + (size_t)(wid * QBLK + r32) * LDQ + 128 + d0 * 16 + hi * 8); }
    SBAR();
    if (hi == 0) li_l[r32] = l_reg; asm volatile("s_waitcnt lgkmcnt(0)" ::: "memory");
    float rli[16];
#pragma unroll
    for (int r = 0; r < 16; ++r) rli[r] = __builtin_amdgcn_rcpf(li_l[crow(r, hi)]);
    bf16_t* Ow = cur.O + (size_t)(wid * QBLK) * LDO;
#pragma unroll
    for (int r = 0; r < 16; ++r) { const int orow = crow(r, hi);
#pragma unroll
        for (int d0 = 0; d0 < 4; ++d0) { const float v = o[d0][r] * rli[r];
            const float vn = __shfl_xor(v, 1);
            if ((r32 & 1) == 0) *(unsigned*)(Ow + (size_t)orow * LDO + d0 * 32 + r32) = cvtpk(v, vn); } }
    VMW(); __syncthreads();
#undef RESC
#undef KBASE
#undef MASKT
#undef ROT
#undef STEP
}
#undef VMW
#undef DMA_TILE
#undef DMA_OFFS

__device__ __forceinline__ BlockRef mla_ref(int bh, int qb, const bf16_t* Q, const bf16_t* KV, const bf16_t* Kpe, bf16_t* O) {
    const int b = bh >> 2, h = bh & 3; BlockRef r; const size_t row0 = (size_t)b * SEQ;
    r.Q = Q + (row0 + (size_t)qb * QB) * 768 + h * DQK; r.O = O + (row0 + (size_t)qb * QB) * DM + h * DV;
    r.K = KV + row0 * 1024 + h * 256; r.V = r.K + DN; r.Kp = Kpe + row0 * DR; r.P0 = qb * QB; return r;
}
__device__ __forceinline__ void mla_phase(char* lds, const bf16_t* Q, const bf16_t* KV, const bf16_t* Kpe, bf16_t* O) {
    constexpr int NQB = SEQ / QB, NX = NQB / 2, TOTAL = BATCH * NH * NX, W = 1 << 30;
    const int stride = gridDim.x; int L = blockIdx.x; if (L >= TOTAL) return;
#define DEC(L_, bh_, x_) do { const int xcd_ = (L_) & 7, k_ = (L_) >> 3; bh_ = (k_ / NX) * 8 + xcd_; x_ = k_ % NX; } while (0)
    int bh, x; DEC(L, bh, x); int pass = 0;
    BlockRef cur = mla_ref(bh, x, Q, KV, Kpe, O);
    Seam<true> S;
    attn_prime<true, 768, 1024, 1024, DM>(cur, W, lds, S);
    for (;;) {
        const bool more_pass = pass == 0, more_item = L + stride < TOTAL, last = !more_pass && !more_item;
        int bhn = bh, xn = x, passn = pass + 1, Ln = L;
        if (!more_pass) { passn = 0; Ln = more_item ? L + stride : L; DEC(Ln, bhn, xn); }
        const BlockRef nxt = last ? cur : mla_ref(bhn, passn ? NQB - 1 - xn : xn, Q, KV, Kpe, O);
        attn_block<true, 768, 1024, 1024, DM>(cur, nxt, SEQ, W, lds, S);
        if (last) break;
        cur = nxt; bh = bhn; x = xn; pass = passn; L = Ln;
    }
#undef DEC
}
__device__ __forceinline__ BlockRef xa_ref(int L, const bf16_t* Q, const bf16_t* KV, bf16_t* O) {
    const int bh = L & 15, qb = L >> 4, b = bh >> 2, h = bh & 3; BlockRef r; const size_t row0 = (size_t)b * SEQ + (size_t)qb * QB;
    r.Q = Q + row0 * XAW + h * 128; r.O = O + row0 * XAW + h * 128;
    r.K = KV + (size_t)b * MEML * 1024 + h * 128; r.V = r.K + XAW; r.Kp = nullptr; r.P0 = MEML; return r;
}
__device__ __forceinline__ void xa_phase(char* lds, const bf16_t* Q, const bf16_t* KV, bf16_t* O) {
    constexpr int TOTAL = BATCH * NH * (SEQ / QB), W = 1 << 30;
    const int stride = gridDim.x; int L = blockIdx.x; if (L >= TOTAL) return;
    BlockRef cur = xa_ref(L, Q, KV, O);
    Seam<false> S;
    attn_prime<false, XAW, 1024, 1024, XAW>(cur, W, lds, S);
    for (;;) {
        const bool last = L + stride >= TOTAL;
        const BlockRef nxt = last ? cur : xa_ref(L + stride, Q, KV, O);
        attn_block<false, XAW, 1024, 1024, XAW>(cur, nxt, MEML, W, lds, S);
        if (last) break;
        cur = nxt; L += stride;
    }
}
#undef KSWZ
#undef SBAR
}

#define LAS __attribute__((address_space(3)))

constexpr int CW_BAR = 4096;
constexpr int LDS_MISC = LDS_BYTES - 64;
#define XB_TMO      128
#define XB_XCNT(j)  (256  + 64 * (j))
#define XB_XSUB(j)  (1280 + 64 * (j))
#define XB_XGEN(j)  (2304 + 64 * (j))
#define XB_TOP      3328
#define XB_TOPGEN   3392
#define XCD_BAR_WORDS 3456
#define XB_SPIN_CAP (1u << 18)

__device__ __forceinline__ unsigned xb_ld(unsigned* p)              { return __hip_atomic_load(p, __ATOMIC_RELAXED, __HIP_MEMORY_SCOPE_AGENT); }
__device__ __forceinline__ unsigned xb_add(unsigned* p, unsigned v) { return __hip_atomic_fetch_add(p, v, __ATOMIC_RELAXED, __HIP_MEMORY_SCOPE_AGENT); }
__device__ __forceinline__ unsigned xb_xcc_id() { return (unsigned)__builtin_amdgcn_s_getreg((3 << 11) | 20) & 0xFu; }
#define XB_SPIN(cond, bar) do { unsigned _sp = 0; while (cond) { __builtin_amdgcn_s_sleep(1); \
    if ((++_sp & 255u) == 0u) { if (xb_ld(&(bar)[XB_TMO])) break; if (_sp > XB_SPIN_CAP) { atomicAdd(&(bar)[XB_TMO], 1u); break; } } } } while (0)

struct XcdBarrier {
    unsigned* bar; unsigned x;
    volatile LAS unsigned* st;
};

__device__ __forceinline__ XcdBarrier xcd_barrier_post(unsigned* bar, volatile LAS unsigned* st) {
    XcdBarrier b; b.bar = bar; b.x = xb_xcc_id(); b.st = st;
    if (threadIdx.x == 0) (void)xb_add(&bar[XB_XCNT(b.x)], 1u);
    return b;
}
__device__ __forceinline__ void xcd_barrier_complete(unsigned* bar, unsigned x, unsigned& nloc, unsigned& nx) {
    const unsigned G = gridDim.x * gridDim.y * gridDim.z;
    unsigned sum, cnt, mine, sp = 0u;
    for (;;) {
        sum = 0u; cnt = 0u; mine = 0u;
#pragma unroll
        for (unsigned j = 0; j < 16; ++j) { const unsigned c = xb_ld(&bar[XB_XCNT(j)]); sum += c; cnt += (c > 0u) ? 1u : 0u; mine = (j == x) ? c : mine; }
        if (sum == G) break;
        __builtin_amdgcn_s_sleep(1);
        if ((++sp & 255u) == 0u) { if (xb_ld(&bar[XB_TMO])) break; if (sp > XB_SPIN_CAP) { atomicAdd(&bar[XB_TMO], 1u); break; } }
    }
    nloc = mine > 0u ? mine : 1u; nx = cnt > 0u ? cnt : 1u;
}

__device__ __forceinline__ void xcd_barrier(const XcdBarrier& b) {
    asm volatile("s_waitcnt vmcnt(0)" ::: "memory");
    __syncthreads();
    if (threadIdx.x == 0) {
        unsigned* bar = b.bar;
        __builtin_amdgcn_s_waitcnt(0);
        unsigned nloc = b.st[0], nx = b.st[1];
        if (nloc == 0u) { xcd_barrier_complete(bar, b.x, nloc, nx); b.st[0] = nloc; b.st[1] = nx; }
        const unsigned old = xb_add(&bar[XB_XSUB(b.x)], 1u);
        const unsigned gen = old / nloc;
        if (old + 1u == (gen + 1u) * nloc) {
            __builtin_amdgcn_fence(__ATOMIC_RELEASE, "agent");
            asm volatile("s_waitcnt vmcnt(0)" ::: "memory");
            const unsigned og = xb_add(&bar[XB_TOP], 1u);
            const unsigned tg = og / nx;
            if (og + 1u == (tg + 1u) * nx) xb_add(&bar[XB_TOPGEN], 1u);
            else XB_SPIN(xb_ld(&bar[XB_TOPGEN]) == tg, bar);
            __builtin_amdgcn_fence(__ATOMIC_ACQUIRE, "agent");
            xb_add(&bar[XB_XGEN(b.x)], 1u);
            asm volatile("s_waitcnt vmcnt(0)" ::: "memory");
        } else {
            XB_SPIN(xb_ld(&bar[XB_XGEN(b.x)]) == gen, bar);
            __builtin_amdgcn_fence(__ATOMIC_ACQUIRE, "agent");
            asm volatile("s_waitcnt vmcnt(0)" ::: "memory");
        }
    }
    __syncthreads();
}

constexpr size_t WB_GU1 = 16 * MiB, WB_GU2 = 27 * MiB, WB_DN1 = 38 * MiB, WB_DN2 = WB_DN1 + 5767168, WB_IN = 49 * MiB, WB_UQ = WB_IN + 3670016,
                 WB_UKV = WB_UQ + 786432, WB_OUT = 54 * MiB, WB_XQ = 56 * MiB, WB_XKV = 57 * MiB, WB_XO = 59 * MiB;
constexpr int NIN = 1792;

template <class DST>
__device__ __forceinline__ void transpose_items(const float* W, int K, int N, const float* gk, bf16_t* WT, DST dst, LAS float* scr, int worker, int nworkers, int lane) {
    const int nblk = N / 32, nitems = (K / 64) * nblk;
    for (int item = worker; item < nitems; item += nworkers) {
        const int kb = item / nblk, nb = item % nblk, k0 = 64 * kb, n0 = 32 * nb;
#pragma unroll 8
        for (int i = 0; i < 32; ++i) { const int kk = 2 * i + (lane >> 5); float w = W[(size_t)(k0 + kk) * N + n0 + (lane & 31)]; if (gk) w *= gk[k0 + kk]; scr[kk * 33 + (lane & 31)] = w; }
        asm volatile("s_waitcnt lgkmcnt(0)" ::: "memory");
        const int cc = lane & 7;
#pragma unroll
        for (int j = 0; j < 4; ++j) { const int n = (lane >> 3) + 8 * j; const LAS float* s = scr + (8 * cc) * 33 + n;
            u32x4 o; o.x = pk2(s[0 * 33], s[1 * 33]); o.y = pk2(s[2 * 33], s[3 * 33]); o.z = pk2(s[4 * 33], s[5 * 33]); o.w = pk2(s[6 * 33], s[7 * 33]);
            *(u32x4*)(WT + (size_t)dst(n0 + n) * K + k0 + 8 * cc) = o; }
        asm volatile("s_waitcnt lgkmcnt(0)" ::: "memory");
    }
}
__device__ __forceinline__ void nrope_kpe(const bf16_t* kper, bf16_t* kpe, const float* cosT, const float* sinT, const Ctx& c) {
    for (int i = c.gt; i < T * 32; i += c.ngt) {
        const int k = i & 31, row = i >> 5;
        const float cs = cosT[i], sn = sinT[i];
        const bf16_t* s = kper + (size_t)row * 64; const float x1 = bf2f(s[k]), x2 = bf2f(s[k + 32]);
        bf16_t* o = kpe + (size_t)row * 64; o[k] = (bf16_t)f2bf(x1 * cs - x2 * sn); o[k + 32] = (bf16_t)f2bf(x2 * cs + x1 * sn);
    }
}

#define MKCTX() int tid_ = threadIdx.x; asm volatile("" : "+v"(tid_)); Ctx c; c.tid = tid_; c.lane = c.tid & 63; c.wave = __builtin_amdgcn_readfirstlane(c.tid >> 6); \
    c.gw = blockIdx.x * NWAVES + c.wave; c.ngw = gridDim.x * NWAVES; c.gt = blockIdx.x * NTHREADS + c.tid; c.ngt = gridDim.x * NTHREADS; float* wl = (float*)lds + c.wave * 256; (void)wl
enum Step { ST_PREP = 0, ST_GU1, ST_DN1, ST_RN1, ST_WIN, ST_QG, ST_KVG, ST_KPE, ST_LRUA, ST_MIX, ST_LRUC, ST_WOUT, ST_RN2, ST_XQ, ST_MEMKV, ST_XATT, ST_XO, ST_RN3, ST_GU2, ST_DN2, ST_RN4, ST_END };

template <int STEP>
__device__ __forceinline__ void do_step(const Params& p, unsigned char* lds) {
    constexpr int step = STEP;
    const int G = gridDim.x, bid = blockIdx.x;
    unsigned char* ws = p.ws;
    float* rs0 = (float*)(ws + WS_RS); float* rs1 = rs0 + T; float* rs2 = rs1 + T; float* rs3 = rs2 + T;
    float* ssq_q = (float*)(ws + WS_SSQQ); float* ssq_kv = (float*)(ws + WS_SSQKV);
    float* cosT = (float*)(ws + WS_COS); float* sinT = (float*)(ws + WS_SIN);
    bf16_t* memn = (bf16_t*)(ws + WS_MEMN); bf16_t* memkv = (bf16_t*)(ws + WS_MEMKV);
    bf16_t* xb = (bf16_t*)(ws + WS_XB); bf16_t* hid = (bf16_t*)(ws + WS_HID);
    bf16_t* cq = (bf16_t*)(ws + WS_CQ); bf16_t* ckv = (bf16_t*)(ws + WS_CKV); bf16_t* kper = (bf16_t*)(ws + WS_KPER); bf16_t* ub = (bf16_t*)(ws + WS_U); bf16_t* gateb = (bf16_t*)(ws + WS_GATE);
    bf16_t* Qb = (bf16_t*)(ws + WS_Q); bf16_t* kpe = (bf16_t*)(ws + WS_KPE); bf16_t* KVb = (bf16_t*)(ws + WS_KV);
    bf16_t* qx = (bf16_t*)(ws + WS_QX); bf16_t* ox = (bf16_t*)(ws + WS_OX); bf16_t* ycat = (bf16_t*)(ws + WS_YCAT);
    float* YA = (float*)(ws + WS_YA); float* YB = (float*)(ws + WS_YB);
    LAS unsigned char* ldsl = (LAS unsigned char*)lds;
        switch (step) {
        case ST_PREP: { MKCTX();
            nrow_prep(p.in[I_X], xb, rs0, T, c);
            nrow_memn(p.in[I_MEM], p.in[I_MEMG], memn, c);
            nrope_tables((const int*)p.in[I_POS], cosT, sinT, c);
            LAS float* scr = (LAS float*)(ldsl + c.wave * 16384);
            int off = 0;
#define TR(W, K, N, GK, DSTP, ...) do { transpose_items(W, K, N, GK, (bf16_t*)(ws + (DSTP)), __VA_ARGS__, scr, (c.gw + c.ngw - (off % c.ngw)) % c.ngw, c.ngw, c.lane); off += ((K) / 64) * ((N) / 32); } while (0)
            auto dgu = [](int n) { const int j = n < DFF ? n : n - DFF; return 256 * (j >> 7) + (n < DFF ? 0 : 128) + (j & 127); };
            auto did = [](int n) { return n; };
            auto din = [](int n) { return n < 704 ? n : n + 64; };
            auto duq = [](int n) { const int h = n / DQK, d = n % DQK; return d < DN ? h * DN + d : (d < DN + 32 ? 512 + 32 * h + (d - DN) : 640 + 32 * h + (d - DN - 32)); };
            TR(p.in[I_F1GU], DM, 2 * DFF, p.in[I_F1PRE], WB_GU1, dgu);
            TR(p.in[I_F2GU], DM, 2 * DFF, p.in[I_F2PRE], WB_GU2, dgu);
            TR(p.in[I_F1DN], DFF, DM, nullptr, WB_DN1, did);
            TR(p.in[I_F2DN], DFF, DM, nullptr, WB_DN2, did);
            TR(p.in[I_WIN], DM, INC, p.in[I_MIXPRE], WB_IN, din);
            TR(p.in[I_WUQ], QLR, NH * DQK, p.in[I_QAG], WB_UQ, duq);
            TR(p.in[I_WUKV], KVLR, NH * 256, p.in[I_KVAG], WB_UKV, did);
            TR(p.in[I_WOUT], DM, DM, nullptr, WB_OUT, did);
            TR(p.in[I_XAWQ], DM, XAW, p.in[I_XAPRE], WB_XQ, did);
            TR(p.in[I_XAWKV], DM, 2 * XAW, nullptr, WB_XKV, did);
            TR(p.in[I_XAWO], XAW, DM, nullptr, WB_XO, did);
#undef TR
            { u32x4* z = (u32x4*)(ws + WB_IN + (size_t)704 * DM * 2); for (int i = c.gt; i < 64 * DM * 2 / 16; i += c.ngt) z[i] = (u32x4){0u, 0u, 0u, 0u}; }
        } break;
        case ST_GU1: case ST_GU2: {
            const bool f1 = step == ST_GU1;
            pg8::Gemm g{xb, (const bf16_t*)(ws + (f1 ? WB_GU1 : WB_GU2)), T, 2 * DFF, DM}; pg8::StaticOrder S; S.init(T, 2 * DFF, G, bid);
            pg8::EpiSwiGLU E{hid, DFF, f1 ? rs0 : rs3};
            pg8::gemm_phase<pg8::EpiSwiGLU, pg8::StaticOrder, true, true>(ldsl, g, S, E);
        } break;
        case ST_DN1: case ST_WOUT: case ST_XO: case ST_DN2: {
            const bf16_t* A = (step == ST_WOUT) ? ycat : (step == ST_XO) ? ox : hid;
            const size_t wb = (step == ST_DN1) ? WB_DN1 : (step == ST_DN2) ? WB_DN2 : (step == ST_WOUT) ? WB_OUT : WB_XO;
            const int K = (step == ST_WOUT) ? DM : (step == ST_XO) ? XAW : DFF;
            float* Y = (step == ST_DN1 || step == ST_DN2) ? YA : YB;
            pg8::Gemm g{A, (const bf16_t*)(ws + wb), T, DM, K}; pg8::StaticOrder S; S.init(T, DM, G, bid);
            pg8::EpiF32 E{Y, DM};
            pg8::gemm_phase<pg8::EpiF32, pg8::StaticOrder, true, true>(ldsl, g, S, E);
        } break;
        case ST_RN1: case ST_RN2: case ST_RN3: case ST_RN4: { MKCTX();
            const float* base = (step == ST_RN1) ? p.in[I_X] : p.out;
            const float* y = (step == ST_RN1 || step == ST_RN4) ? YA : YB;
            const float* g = p.in[(step == ST_RN1) ? I_F1POST : (step == ST_RN2) ? I_MIXPOST : (step == ST_RN3) ? I_XAPOST : I_F2POST];
            const float coef = (step == ST_RN1 || step == ST_RN4) ? 0.5f : 1.0f;
            float* rso = (step == ST_RN1) ? rs1 : (step == ST_RN2) ? rs2 : (step == ST_RN3) ? rs3 : rs0;
            nrow_resnorm(base, y, g, coef, p.out, xb, rso, c);
        } break;
        case ST_WIN: {
            pg8::Gemm g{xb, (const bf16_t*)(ws + WB_IN), T, NIN, DM}; pg8::StaticOrder S; S.init(T, NIN, G, bid);
            pg8::EpiWin E{cq, ckv, kper, ub, gateb, rs1, ssq_q, ssq_kv};
            pg8::gemm_phase<pg8::EpiWin, pg8::StaticOrder, true, true>(ldsl, g, S, E);
        } break;
        case ST_QG: {
            pg8::Gemm g{cq, (const bf16_t*)(ws + WB_UQ), T, NH * DQK, QLR}; pg8::StaticOrder S; S.init(T, NH * DQK, G, bid);
            pg8::EpiQ E{Qb, ssq_q, cosT, sinT};
            pg8::gemm_phase<pg8::EpiQ, pg8::StaticOrder, true, true>(ldsl, g, S, E);

        } break;
        case ST_KVG: case ST_XQ: case ST_MEMKV: {
            const bf16_t* A = (step == ST_KVG) ? ckv : (step == ST_XQ) ? xb : memn;
            const size_t wb = (step == ST_KVG) ? WB_UKV : (step == ST_XQ) ? WB_XQ : WB_XKV;
            const int M = (step == ST_MEMKV) ? MT : T, N = (step == ST_XQ) ? XAW : 1024, K = (step == ST_KVG) ? KVLR : DM;
            bf16_t* O = (step == ST_KVG) ? KVb : (step == ST_XQ) ? qx : memkv;
            pg8::Gemm g{A, (const bf16_t*)(ws + wb), M, N, K}; pg8::StaticOrder S; S.init(M, N, G, bid);
            pg8::EpiRowScale E{O, N, (step == ST_KVG) ? 2 : (step == ST_XQ) ? 1 : 0, (step == ST_KVG) ? ssq_kv : rs2, 8, 1.0f / KVLR};
            pg8::gemm_phase<pg8::EpiRowScale, pg8::StaticOrder, true, true>(ldsl, g, S, E);

        } break;
        case ST_KPE: { MKCTX(); nrope_kpe(kper, kpe, cosT, sinT, c); } break;
        case ST_LRUA: { MKCTX();
            for (int item = bid; item < BATCH * NCHUNK; item += G)
                lru_a(ub, p.in[I_CONVW], p.in[I_CONVB], p.in[I_RGWA], p.in[I_RGBA], p.in[I_RGWX], p.in[I_RGBX], p.in[I_LAM], (bf16_t*)(ws + WS_LRUH), (bf16_t*)(ws + WS_LRUP),
                      (float*)(ws + WS_LRUSUM), (float*)(ws + WS_LRUSUM) + BATCH * NCHUNK * LRUW, item, wl, c.wave, c.lane);
        } break;
        case ST_LRUC: { MKCTX();
            for (int item = bid; item < BATCH * NCHUNK; item += G)
                lru_c((const bf16_t*)(ws + WS_LRUH), (const bf16_t*)(ws + WS_LRUP), gateb, (const float*)(ws + WS_LRUSUM), (const float*)(ws + WS_LRUSUM) + BATCH * NCHUNK * LRUW, ycat, item, (float*)lds, c.tid);
        } break;
        case ST_MIX: att::mla_phase((char*)lds, Qb, KVb, kpe, ycat); break;
        case ST_XATT: att::xa_phase((char*)lds, qx, memkv, ox); break;
        default: break;
        }
}
__device__ __forceinline__ constexpr bool step_sync(int s) { return !(s == ST_QG || s == ST_KVG || s == ST_KPE || s == ST_MIX || s == ST_XQ || s == ST_END - 1); }
template <int STEP> __device__ __forceinline__ void run_steps(const Params& p, unsigned char* lds, cg::grid_group& grid, const XcdBarrier& bar) {
    if constexpr (STEP < ST_END) {
        do_step<STEP>(p, lds);
        if constexpr (step_sync(STEP)) { if constexpr (STEP == ST_PREP) grid.sync(); else xcd_barrier(bar); }
        run_steps<STEP + 1>(p, lds, grid, bar);
    }
}
__global__ void __launch_bounds__(NTHREADS, 2) fwd_kernel(Params p) {
    cg::grid_group grid = cg::this_grid();
    extern __shared__ __attribute__((aligned(16))) unsigned char lds[];
    volatile LAS unsigned* misc = (volatile LAS unsigned*)((LAS unsigned char*)lds + LDS_MISC);
    if (threadIdx.x < 16) misc[threadIdx.x] = 0u;
    __syncthreads();
    const XcdBarrier bar = xcd_barrier_post((unsigned*)(p.ws + WS_CTL) + CW_BAR, misc);
    run_steps<0>(p, lds, grid, bar);
}

extern "C" void kernel_launch(void* const* d_in, const int* in_sizes, int n_in, void* d_out, int out_size, void* d_ws, size_t ws_size, hipStream_t stream) {
    static int grid_blocks = 0;
    if (grid_blocks == 0) {
        if (n_in != 32 || out_size != T * DM || ws_size < WS_END) { fprintf(stderr, "kernel_launch: unexpected shapes (n_in %d out %d ws %zu)\n", n_in, out_size, ws_size); grid_blocks = -1; return; }
        int dev = 0, cus = 0, per_cu = 0;
        (void)hipGetDevice(&dev);
        (void)hipDeviceGetAttribute(&cus, hipDeviceAttributeMultiprocessorCount, dev);
        (void)hipFuncSetAttribute((const void*)fwd_kernel, hipFuncAttributeMaxDynamicSharedMemorySize, LDS_BYTES);
        (void)hipOccupancyMaxActiveBlocksPerMultiprocessor(&per_cu, (const void*)fwd_kernel, NTHREADS, LDS_BYTES);
        if (per_cu < 1) { fprintf(stderr, "kernel_launch: occupancy query says %d blocks per CU\n", per_cu); per_cu = 1; }
        if (per_cu > 1) per_cu = 1;
        grid_blocks = cus * per_cu;
        (void)hipGetLastError();
    }
    if (grid_blocks < 0) return;
    (void)hipMemsetAsync((char*)d_ws + WS_CTL, 0, CTL_ZERO_BYTES, stream);
    Params p{};
    for (int i = 0; i < 32; ++i) p.in[i] = (const float*)d_in[i];
    p.out = (float*)d_out; p.ws = (unsigned char*)d_ws;
    void* args[] = {&p};
    hipError_t e = hipLaunchCooperativeKernel((const void*)fwd_kernel, dim3(grid_blocks), dim3(NTHREADS), args, LDS_BYTES, stream);
    if (e != hipSuccess) fprintf(stderr, "cooperative launch failed: %s (grid %d)\n", hipGetErrorString(e), grid_blocks);
}
```
